# Optimizing an MI355X kernel written in HIP

```python
import jax, jax.numpy as jnp
from jax import lax
import numpy as np

D_MODEL = 1024
BATCH = 8
SEQ = 8192
DEPTH = 2

GRID_W = 64
CTX_LEN = 256
N_MIXERS = 2
N_A_LAYERS = (DEPTH + 1) // 2
N_B_LAYERS = DEPTH // 2
CHUNK = 128
GM_HALF = 3 * D_MODEL
GM_GROUPS = 8
GM_GROUP_DIM = GM_HALF // GM_GROUPS
HG_HEADS = 8
HG_KEY_DIM = D_MODEL // HG_HEADS
HG_VAL_DIM = D_MODEL // HG_HEADS
HG_KEY = HG_HEADS * HG_KEY_DIM
HG_VAL = HG_HEADS * HG_VAL_DIM
HG_PROJ = 3 * HG_KEY + 2 * HG_VAL
SCAN_CHUNK = 64
D_FF = ((8 * D_MODEL // 3 + 255) // 256) * 256
NORM_EPS = 1e-6
POS_BASE = 10000.0

kernel_name = 'hybrid_gmlp_hgrn2_prefix_dit'


def rms_norm(x, w):
    xf = x.astype(jnp.float32)
    xf = xf * lax.rsqrt(jnp.mean(xf * xf, axis=-1, keepdims=True) + NORM_EPS)
    return (xf * w.astype(jnp.float32)).astype(x.dtype)


def layer_norm(x, g, b):
    xf = x.astype(jnp.float32)
    mu = jnp.mean(xf, axis=-1, keepdims=True)
    xc = xf - mu
    var = jnp.mean(xc * xc, axis=-1, keepdims=True)
    return (xc * lax.rsqrt(var + NORM_EPS) * g.astype(jnp.float32) + b.astype(jnp.float32)).astype(x.dtype)


def ada_modulate(x, w, shift, scale):
    return rms_norm(x, w) * (1.0 + scale) + shift


def sincos(pos, dim):
    half = dim // 2
    omega = 1.0 / (POS_BASE ** (jnp.arange(half, dtype=jnp.float32) / half))
    ang = pos.astype(jnp.float32)[:, None] * omega[None, :]
    return jnp.concatenate([jnp.sin(ang), jnp.cos(ang)], axis=-1)


def grid_pos_code(n):
    rows = n // GRID_W
    half = D_MODEL // 2
    row_code = sincos(jnp.arange(rows), half)
    col_code = sincos(jnp.arange(GRID_W), half)
    code = jnp.concatenate([
        jnp.broadcast_to(row_code[:, None, :], (rows, GRID_W, half)),
        jnp.broadcast_to(col_code[None, :, :], (rows, GRID_W, half))], axis=-1)
    return code.reshape(rows * GRID_W, D_MODEL)


def chunk_gmlp(h, w_in, b_in, ln_g, ln_b, w_s, b_s, w_out):
    bsz, n, _ = h.shape
    z = jax.nn.gelu(h @ w_in + b_in, approximate=False)
    u, v = jnp.split(z, 2, axis=-1)
    v = layer_norm(v, ln_g, ln_b)
    v = v.reshape(bsz, n // CHUNK, CHUNK, GM_GROUPS, GM_GROUP_DIM)
    v = jnp.einsum('gpq,bcqgd->bcpgd', w_s, v) + b_s.T[:, :, None]
    v = v.reshape(bsz, n, GM_HALF)
    return (u * v) @ w_out


def gla_chunked(q, k, v, log_f, s0):
    bsz, n, h, _ = q.shape
    dv = v.shape[-1]
    nc = n // SCAN_CHUNK

    def blocks(t):
        return t.astype(jnp.float32).reshape(bsz, nc, SCAN_CHUNK, h, t.shape[-1])

    q, k, v, log_f = blocks(q), blocks(k), blocks(v), blocks(log_f)
    b = jnp.cumsum(log_f, axis=2)
    b_last = b[:, :, -1:]
    q_dec = q * jnp.exp(b)
    k_inv = k * jnp.exp(-b)
    k_dec = k * jnp.exp(b_last - b)
    lower = jnp.tril(jnp.ones((SCAN_CHUNK, SCAN_CHUNK), dtype=bool))
    att = jnp.einsum('bcthk,bcshk->bchts', q_dec, k_inv)
    att = jnp.where(lower, att, 0.0)
    o_intra = jnp.einsum('bchts,bcshv->bcthv', att, v)

    def step(state, xs):
        q_c, k_c, v_c, d_c = xs
        o_c = jnp.einsum('bthk,bhkv->bthv', q_c, state)
        state = d_c[..., None] * state + jnp.einsum('bshk,bshv->bhkv', k_c, v_c)
        return state, o_c

    xs = (jnp.moveaxis(q_dec, 1, 0), jnp.moveaxis(k_dec, 1, 0), jnp.moveaxis(v, 1, 0),
          jnp.moveaxis(jnp.exp(b_last[:, :, 0]), 1, 0))
    s_final, o_inter = lax.scan(step, s0, xs)
    o = o_intra + jnp.moveaxis(o_inter, 0, 1)
    return o.reshape(bsz, n, h, dv), s_final


def scan_final_state(k, v, log_f):
    b = jnp.cumsum(log_f.astype(jnp.float32), axis=1)
    k_dec = k.astype(jnp.float32) * jnp.exp(b[:, -1:] - b)
    return jnp.einsum('bshk,bshv->bhkv', k_dec, v.astype(jnp.float32))


def hg_forget(z, lb):
    zf = z.astype(jnp.float32)
    log_f = jnp.logaddexp(jnp.log(lb), jnp.log1p(-lb) + jax.nn.log_sigmoid(zf))
    key = (1.0 - lb) * jax.nn.sigmoid(-zf)
    return key, log_f


def hgrn2_mixer(h_lat, h_ctx, w_in, lower_bound, norm_w, w_out, ctx_out):
    bsz = h_lat.shape[0]
    lbs = lower_bound.astype(jnp.float32).reshape(2, HG_HEADS, HG_KEY_DIM)
    cuts = [HG_KEY, 2 * HG_KEY, 3 * HG_KEY, 3 * HG_KEY + HG_VAL]

    def heads(t, d):
        return t.reshape(t.shape[0], t.shape[1], HG_HEADS, d)

    def rev(t):
        return jnp.flip(t, axis=1)

    def readout(o, g):
        o = rms_norm(o, norm_w.reshape(HG_HEADS, HG_VAL_DIM))
        o = o.reshape(o.shape[0], o.shape[1], HG_VAL).astype(g.dtype) * jax.nn.silu(g)
        return o @ w_out

    q_x, ff_x, fb_x, i_x, g_x = jnp.split(h_lat @ w_in, cuts, axis=-1)
    q_x = heads(jax.nn.silu(q_x), HG_KEY_DIM)
    i_x = heads(i_x, HG_VAL_DIM)
    kf_x, lf_x = hg_forget(heads(ff_x, HG_KEY_DIM), lbs[0])
    kb_x, lbk_x = hg_forget(heads(fb_x, HG_KEY_DIM), lbs[1])

    if ctx_out:
        q_c, ff_c, fb_c, i_c, g_c = jnp.split(h_ctx @ w_in, cuts, axis=-1)
        q_c = heads(jax.nn.silu(q_c), HG_KEY_DIM)
        i_c = heads(i_c, HG_VAL_DIM)
        kf_c, lf_c = hg_forget(heads(ff_c, HG_KEY_DIM), lbs[0])
        kb_c, lbk_c = hg_forget(heads(fb_c, HG_KEY_DIM), lbs[1])
        zero = jnp.zeros((bsz, HG_HEADS, HG_KEY_DIM, HG_VAL_DIM), jnp.float32)
        o_cf, s_f = gla_chunked(q_c, kf_c, i_c, lf_c, zero)
        o_cb, s_b = gla_chunked(rev(q_c), rev(kb_c), rev(i_c), rev(lbk_c), zero)
        y_ctx = readout(o_cf + rev(o_cb), g_c)
    else:
        ff_c, fb_c, i_c = jnp.split(h_ctx @ w_in[:, HG_KEY:3 * HG_KEY + HG_VAL], [HG_KEY, 2 * HG_KEY], axis=-1)
        i_c = heads(i_c, HG_VAL_DIM)
        kf_c, lf_c = hg_forget(heads(ff_c, HG_KEY_DIM), lbs[0])
        kb_c, lbk_c = hg_forget(heads(fb_c, HG_KEY_DIM), lbs[1])
        s_f = scan_final_state(kf_c, i_c, lf_c)
        s_b = scan_final_state(rev(kb_c), rev(i_c), rev(lbk_c))
        y_ctx = None

    o_f, _ = gla_chunked(q_x, kf_x, i_x, lf_x, s_f)
    o_b, _ = gla_chunked(rev(q_x), rev(kb_x), rev(i_x), rev(lbk_x), s_b)
    y_lat = readout(o_f + rev(o_b), g_x)
    return y_lat, y_ctx


def swiglu(h, w_in, w_out):
    a, b = jnp.split(h @ w_in, 2, axis=-1)
    return (jax.nn.silu(a) * b) @ w_out


def setup_inputs(seed: int = 0) -> dict:
    key = jax.random.key(seed)
    ks = iter(jax.random.split(key, 22))
    D = D_MODEL

    def nrm(shape, s):
        return jax.random.normal(next(ks), shape, jnp.float32) * s

    return {
        'x': nrm((BATCH, SEQ, D), 1.0),
        'c': nrm((BATCH, D), 1.0),
        'ctx': nrm((BATCH, CTX_LEN, D), 1.0),
        'c_ctx': nrm((D,), 1.0),
        'ada_w': nrm((DEPTH, D, 6 * D), D ** -0.5),
        'ada_b': nrm((DEPTH, 6 * D), 0.01),
        'norm_mix_w': 1.0 + nrm((DEPTH, D), 0.02),
        'norm_ffn_w': 1.0 + nrm((DEPTH, D), 0.02),
        'gm_w_in': nrm((N_A_LAYERS, D, 2 * GM_HALF), D ** -0.5),
        'gm_b_in': nrm((N_A_LAYERS, 2 * GM_HALF), 0.01),
        'gm_ln_g': 1.0 + nrm((N_A_LAYERS, GM_HALF), 0.02),
        'gm_ln_b': nrm((N_A_LAYERS, GM_HALF), 0.01),
        'gm_w_s': nrm((N_A_LAYERS, GM_GROUPS, CHUNK, CHUNK), CHUNK ** -0.5),
        'gm_b_s': 1.0 + nrm((N_A_LAYERS, GM_GROUPS, CHUNK), 0.02),
        'gm_w_out': nrm((N_A_LAYERS, GM_HALF, D), GM_HALF ** -0.5),
        'hg_w_in': nrm((N_B_LAYERS, D, HG_PROJ), D ** -0.5),
        'hg_lb': nrm((DEPTH, 2, HG_KEY), 0.1),
        'hg_norm_w': 1.0 + nrm((N_B_LAYERS, HG_VAL), 0.02),
        'hg_w_out': nrm((N_B_LAYERS, HG_VAL, D), HG_VAL ** -0.5),
        'ffn_w_in': nrm((DEPTH, D, 2 * D_FF), D ** -0.5),
        'ffn_w_out': nrm((DEPTH, D_FF, D), D_FF ** -0.5),
        'final_norm_w': 1.0 + nrm((D,), 0.02),
    }


def reference(x, c, ctx, c_ctx, ada_w, ada_b, norm_mix_w, norm_ffn_w, gm_w_in, gm_b_in, gm_ln_g, gm_ln_b,
              gm_w_s, gm_b_s, gm_w_out, hg_w_in, hg_lb, hg_norm_w, hg_w_out, ffn_w_in, ffn_w_out, final_norm_w):
    n = x.shape[1]
    x = x + grid_pos_code(n).astype(x.dtype)
    p = jax.nn.softmax(hg_lb.astype(jnp.float32), axis=0)
    lower_bounds = jnp.cumsum(p, axis=0) - p[0]
    s_lat = jax.nn.silu(c)
    s_ctx = jax.nn.silu(c_ctx)

    for i in range(DEPTH):
        last = i == DEPTH - 1
        use_a = i % N_MIXERS == 0
        j = i // N_MIXERS
        ctx_needed = (not last) or (not use_a)

        mod_lat = (s_lat @ ada_w[i] + ada_b[i])[:, None, :]
        sh_m, sc_m, gt_m, sh_f, sc_f, gt_f = jnp.split(mod_lat, 6, axis=-1)
        h_lat = ada_modulate(x, norm_mix_w[i], sh_m, sc_m)
        if ctx_needed:
            mod_ctx = s_ctx @ ada_w[i] + ada_b[i]
            csh_m, csc_m, cgt_m, csh_f, csc_f, cgt_f = jnp.split(mod_ctx, 6, axis=-1)
            h_ctx = ada_modulate(ctx, norm_mix_w[i], csh_m, csc_m)

        if use_a:
            gm = (gm_w_in[j], gm_b_in[j], gm_ln_g[j], gm_ln_b[j], gm_w_s[j], gm_b_s[j], gm_w_out[j])
            y_lat = chunk_gmlp(h_lat, *gm)
            y_ctx = None if last else chunk_gmlp(h_ctx, *gm)
        else:
            y_lat, y_ctx = hgrn2_mixer(h_lat, h_ctx, hg_w_in[j], lower_bounds[i], hg_norm_w[j],
                                       hg_w_out[j], not last)

        x = x + gt_m * y_lat
        x = x + gt_f * swiglu(ada_modulate(x, norm_ffn_w[i], sh_f, sc_f), ffn_w_in[i], ffn_w_out[i])
        if not last:
            ctx = ctx + cgt_m * y_ctx
            ctx = ctx + cgt_f * swiglu(ada_modulate(ctx, norm_ffn_w[i], csh_f, csc_f), ffn_w_in[i], ffn_w_out[i])

    return rms_norm(x, final_norm_w)
```

```cpp
#include <hip/hip_runtime.h>
#include <hip/hip_cooperative_groups.h>
#include <cstdio>
namespace cg = cooperative_groups;

#ifndef COOP
#define COOP 1
#endif

#ifndef PROBE_MASK
#define PROBE_MASK 0
#endif
#define DUP(k) ((PROBE_MASK >> (k)) & 1)
#define LAS __attribute__((address_space(3)))
typedef unsigned short bf16_t;
typedef short bf16x8 __attribute__((ext_vector_type(8)));
typedef float f32x4 __attribute__((ext_vector_type(4)));
typedef float f32x2 __attribute__((ext_vector_type(2)));
typedef unsigned u32x4 __attribute__((ext_vector_type(4)));
typedef unsigned u32x2 __attribute__((ext_vector_type(2)));

constexpr int MLAT = 65536, MCTX = 2048, MALL = 67584;
constexpr float EPS = 1e-6f;
constexpr int NPHASE = 17;
constexpr int XOFF = 131072 + 64;
constexpr int LDS_BYTES = 163840;
constexpr int BST_OFF = 163840 - 64;

constexpr size_t SECE = (size_t)MALL * 1024;
constexpr size_t SEC = SECE * 2;
constexpr size_t OFF_XC = 0;
constexpr size_t OFF_H = 8388608;
constexpr size_t OFF_U = OFF_H + SEC;
constexpr size_t OFF_V = OFF_U + 3 * SEC;
constexpr size_t OFF_W = OFF_V + 3 * SEC;
constexpr size_t W_GMIN = OFF_W;
constexpr size_t W_GMOUT = W_GMIN + (size_t)6144 * 1024 * 2;
constexpr size_t W_HGIN = W_GMOUT + (size_t)1024 * 3072 * 2;
constexpr size_t W_HGOUT = W_HGIN + (size_t)5120 * 1024 * 2;
constexpr size_t W_FFIN = W_HGOUT + (size_t)1024 * 1024 * 2;
constexpr size_t W_FFOUT = W_FFIN + (size_t)2 * 5632 * 1024 * 2;
constexpr size_t W_WS = W_FFOUT + (size_t)2 * 1024 * 2816 * 2;
constexpr size_t OFF_MOD = W_WS + (size_t)8 * 128 * 128 * 2;
constexpr size_t OFF_STATS = OFF_MOD + (size_t)2 * 9 * 6144 * 4;
constexpr size_t OFF_POS = OFF_STATS + (size_t)MALL * 2 * 8;
constexpr size_t OFF_LB = OFF_POS + (size_t)192 * 512 * 4;
constexpr size_t OFF_SS = OFF_LB + 2048 * 4;
constexpr size_t OFF_SHB = OFF_SS + (size_t)3 * MALL * 8;
constexpr size_t OFF_GN = OFF_SHB + (size_t)3 * 9 * 5632 * 4;
constexpr size_t OFF_BAR = OFF_GN + (size_t)3 * 9 * 1024 * 4;
constexpr size_t BAR_BYTES = 3456 * 4;
constexpr size_t WS_END = OFF_BAR + 16384;

struct Params { const float* in[22]; float* out; unsigned char* ws; int ph_lo, ph_hi; };

typedef __bf16 bf16x2_t __attribute__((ext_vector_type(2)));
__device__ __forceinline__ unsigned cvt_pk_bf16(float lo, float hi) { const f32x2 v = {lo, hi}; const bf16x2_t r = __builtin_convertvector(v, bf16x2_t); return __builtin_bit_cast(unsigned, r); }
__device__ __forceinline__ float bf2f(unsigned short b) { return __uint_as_float(((unsigned)b) << 16); }
__device__ __forceinline__ float bflo(unsigned w) { return __uint_as_float(w << 16); }
__device__ __forceinline__ float bfhi(unsigned w) { return __uint_as_float(w & 0xffff0000u); }
__device__ __forceinline__ float wave_sum(float v) {
#pragma unroll
    for (int o = 1; o < 64; o <<= 1) v += __shfl_xor(v, o);
    return v;
}
__device__ __forceinline__ float silu_f(float a) { return a * __builtin_amdgcn_rcpf(1.0f + __expf(-a)); }
#define LDS_WAIT() asm volatile("s_waitcnt lgkmcnt(0)" ::: "memory")
#define MFMA16(a, b, c) __builtin_amdgcn_mfma_f32_16x16x32_bf16((a), (b), (c), 0, 0, 0)

__device__ __forceinline__ f32x2 gelu_pk(f32x2 v) {
    const f32x2 av = __builtin_elementwise_abs(v), d = av * 0.2316418882f + 1.0f;
    f32x2 t; t.x = __builtin_amdgcn_rcpf(d.x); t.y = __builtin_amdgcn_rcpf(d.y);
    f32x2 q = t * 0.5307027145f + (-0.7265760135f); q = q * t + 0.7107068705f; q = q * t + (-0.142248368f); q = q * t + 0.127414796f; q = q * t;
    const f32x2 s = (v * v) * (-0.72134752044f);
    f32x2 e; e.x = __builtin_amdgcn_exp2f(s.x); e.y = __builtin_amdgcn_exp2f(s.y);
    const f32x2 z = {0.f, 0.f};
    return __builtin_elementwise_max(v, z) - av * (q * e);
}

constexpr int BM = 256, BK = 64, HALF = 128, HTB = HALF * BK * 2, NXCD = 8, WGM = 8;
__device__ __forceinline__ int lds_byte(int r, int c) { const int st = (r >> 4) * 2 + (c >> 5), rr = r & 15, cc = c & 31, ob = rr * 64 + cc * 2; return st * 1024 + (ob ^ (((ob >> 9) & 1) << 5)); }
__device__ __forceinline__ void stage_rc(int b, int& R, int& C) { const int st = b / 1024, sb = b % 1024, swz = sb ^ (((sb >> 9) & 1) << 5); R = (st >> 1) * 16 + swz / 64; C = (st & 1) * 32 + (swz % 64) / 2; }
__device__ __forceinline__ int perm32(int rho) { const int n = rho >> 4, i = rho & 15; return 8 * (i >> 2) + 4 * n + (i & 3); }

struct Unit { int pm, pn; };
struct StaticOrder {
    int nM, nN, nwg, G, c;
    __device__ void init(int M, int N, int G_, int c_) { nM = M / BM; nN = N / BM; nwg = nM * nN; G = G_; c = c_; }
    __device__ bool next(int i, Unit& u) const {
        const long L = (long)i * G + c; if (L >= nwg) return false;
        int wgid = (int)L; { const int q = nwg / NXCD, r = nwg % NXCD, xcd = wgid % NXCD, off = wgid / NXCD; wgid = (xcd < r ? xcd * (q + 1) : r * (q + 1) + (xcd - r) * q) + off; }
        const int nig = WGM * nN, gid = wgid / nig, fm = gid * WGM, gsz = (nM - fm) < WGM ? (nM - fm) : WGM;
        u.pm = fm + ((wgid % nig) % gsz); u.pn = (wgid % nig) / gsz; return true;
    }
};

template <int kind> struct Epi {
    static constexpr bool perm = true;
    static constexpr bool PRE = (kind == 3 || kind == 4);
    __device__ __forceinline__ void pre(LAS unsigned char* lx, const Unit& u, int wid, int lane) const {
        if constexpr (PRE) {
            const unsigned* src = (const unsigned*)(ssr + (size_t)u.pm * BM) + wid * 64 + lane;
            __builtin_amdgcn_global_load_lds(src, (LAS unsigned*)(lx + wid * 256), 4, 0, 0);
            if (wid < 4) { const int bi = u.pm * BM < MLAT ? ((u.pm * BM) >> 13) : 8; const float* s2 = shb + bi * shn + u.pn * BM + wid * 64 + lane;
                __builtin_amdgcn_global_load_lds((const unsigned*)s2, (LAS unsigned*)(lx + 2048 + wid * 256), 4, 0, 0); }
        }
    }
    bf16_t* U; bf16_t* V; const float* bias; unsigned long long* stats;
    float* xlat; float* xctx; const float* gate;
    bf16_t* xg; const float* gn; unsigned long long* ssw;
    const long long* ssr; const float* shb; int shn;
    bf16_t* hid;
    bf16_t* proj; const float* lbtab;
    __device__ __forceinline__ void operator()(const f32x4 (&acc)[2][2][4][2], const Unit& u, int wr, int wc, int fr, int fq, LAS unsigned char* lx) const {
        if constexpr (kind == 1) {
            const int row0 = u.pm * BM + wr * 64 + fr; int colt = u.pn * BM; const bool vh = colt >= 3072; bf16_t* base = vh ? V : U; if (vh) colt -= 3072;
            const int col0 = colt + wc * 32 + 8 * fq, bcol0 = u.pn * BM + wc * 32 + 8 * fq;
            f32x4 bv[2][2];
#pragma unroll
            for (int bj = 0; bj < 2; ++bj)
#pragma unroll
                for (int n = 0; n < 2; ++n) bv[bj][n] = *(const f32x4*)(bias + bcol0 + bj * HALF + 4 * n);
#pragma unroll
            for (int ai = 0; ai < 2; ++ai)
#pragma unroll
                for (int m = 0; m < 4; ++m) {
                    const int row = row0 + ai * HALF + m * 16; bf16_t* rowp = base + (size_t)row * 3072 + col0; float s = 0.f, ss = 0.f;
#pragma unroll
                    for (int bj = 0; bj < 2; ++bj) {
                        f32x4 v0 = acc[ai][bj][m][0] + bv[bj][0], v1 = acc[ai][bj][m][1] + bv[bj][1];
                        f32x2 a = (f32x2){v0[0], v0[1]}, b = (f32x2){v0[2], v0[3]}, c = (f32x2){v1[0], v1[1]}, d = (f32x2){v1[2], v1[3]};
                        if (vh) { a = gelu_pk(a); b = gelu_pk(b); c = gelu_pk(c); d = gelu_pk(d);
                            s += (a.x + a.y) + (b.x + b.y) + (c.x + c.y) + (d.x + d.y);
                            ss += (a.x * a.x + a.y * a.y) + (b.x * b.x + b.y * b.y) + (c.x * c.x + c.y * c.y) + (d.x * d.x + d.y * d.y); }
                        u32x4 w; w.x = cvt_pk_bf16(a.x, a.y); w.y = cvt_pk_bf16(b.x, b.y); w.z = cvt_pk_bf16(c.x, c.y); w.w = cvt_pk_bf16(d.x, d.y);
                        *(u32x4*)(rowp + bj * HALF) = w;
                    }
                    if (vh) {
                        s += __shfl_xor(s, 16); s += __shfl_xor(s, 32); ss += __shfl_xor(ss, 16); ss += __shfl_xor(ss, 32);
                        if (fq == 0) { atomicAdd(stats + 2 * row, (unsigned long long)(long long)llrintf(s * 1048576.0f)); atomicAdd(stats + 2 * row + 1, (unsigned long long)(long long)llrintf(ss * 1048576.0f)); }
                    }
                }
        } else if constexpr (kind == 2 || kind == 5) {
            const int rowbase = u.pm * BM; const int bi = rowbase >> 13;
            bf16_t* Xb = (bf16_t*)xlat + (size_t)rowbase * 2048;
            const int col0 = u.pn * BM + wc * 32 + 8 * fq; const float* gp = gate + bi * 6144 + col0;
            float ss[2][4];
#pragma unroll
            for (int ai = 0; ai < 2; ++ai)
#pragma unroll
                for (int m = 0; m < 4; ++m) ss[ai][m] = 0.f;
#pragma unroll
            for (int bj = 0; bj < 2; ++bj) {
                const int co = col0 + bj * HALF;
                const f32x4 gv0 = *(const f32x4*)(gp + bj * HALF), gv1 = *(const f32x4*)(gp + bj * HALF + 4);
                f32x4 gn0 = gv0, gn1 = gv1; if constexpr (kind == 2) { gn0 = *(const f32x4*)(gn + bi * 1024 + co); gn1 = *(const f32x4*)(gn + bi * 1024 + co + 4); }
#pragma unroll
                for (int ai = 0; ai < 2; ++ai) {
                u32x4 xin[4];
#pragma unroll
                    for (int m = 0; m < 4; ++m) xin[m] = *(const u32x4*)(Xb + (size_t)(wr * 64 + fr + ai * HALF + m * 16) * 2048 + co);
#pragma unroll
                    for (int m = 0; m < 4; ++m) { const int rl = wr * 64 + fr + ai * HALF + m * 16; const u32x4 xi = xin[m];
                        const f32x4 x0 = (f32x4){bflo(xi.x), bfhi(xi.x), bflo(xi.y), bfhi(xi.y)} + gv0 * acc[ai][bj][m][0], x1 = (f32x4){bflo(xi.z), bfhi(xi.z), bflo(xi.w), bfhi(xi.w)} + gv1 * acc[ai][bj][m][1];
                        u32x4 xo; xo.x = cvt_pk_bf16(x0[0], x0[1]); xo.y = cvt_pk_bf16(x0[2], x0[3]); xo.z = cvt_pk_bf16(x1[0], x1[1]); xo.w = cvt_pk_bf16(x1[2], x1[3]);
                        *(u32x4*)(Xb + (size_t)rl * 2048 + co) = xo;
                        if constexpr (kind == 2) {
                            ss[ai][m] += ((x0[0] * x0[0] + x0[1] * x0[1]) + (x0[2] * x0[2] + x0[3] * x0[3])) + ((x1[0] * x1[0] + x1[1] * x1[1]) + (x1[2] * x1[2] + x1[3] * x1[3]));
                            const f32x4 y0 = x0 * gn0, y1 = x1 * gn1;
                            u32x4 o; o.x = cvt_pk_bf16(y0[0], y0[1]); o.y = cvt_pk_bf16(y0[2], y0[3]); o.z = cvt_pk_bf16(y1[0], y1[1]); o.w = cvt_pk_bf16(y1[2], y1[3]);
                            *(u32x4*)(xg + (size_t)(rowbase + rl) * 1024 + co) = o; } }
                }
            }
            if constexpr (kind == 2) {
#pragma unroll
                for (int ai = 0; ai < 2; ++ai)
#pragma unroll
                    for (int m = 0; m < 4; ++m) { float t = ss[ai][m]; t += __shfl_xor(t, 16); t += __shfl_xor(t, 32);
                        if (fq == 0) atomicAdd(ssw + rowbase + wr * 64 + fr + ai * HALF + m * 16, (unsigned long long)(long long)llrintf(t * 1048576.0f)); }
            }
        } else if constexpr (kind == 3) {
            const int rowbase = u.pm * BM; const int bi = rowbase < MLAT ? (rowbase >> 13) : 8;
            const int row0 = rowbase + wr * 64 + fr, col0 = u.pn * HALF + wc * 32 + 8 * fq;
            const LAS float* sp = (const LAS float*)(lx + 2048) + wc * 32 + 8 * fq;
            const f32x4 sa0 = *(const LAS f32x4*)sp, sa1 = *(const LAS f32x4*)(sp + 4), sb0 = *(const LAS f32x4*)(sp + HALF), sb1 = *(const LAS f32x4*)(sp + HALF + 4);
#pragma unroll
            for (int ai = 0; ai < 2; ++ai)
#pragma unroll
                for (int m = 0; m < 4; ++m) { const int row = row0 + ai * HALF + m * 16; bf16_t* rowp = hid + (size_t)row * 2816 + col0;
                    const float rs = __builtin_amdgcn_rsqf((float)(*(const LAS long long*)(lx + (wr * 64 + fr + ai * HALF + m * 16) * 8)) * (1.0f / (1048576.0f * 1024.0f)) + EPS);
                    const f32x4 a0 = acc[ai][0][m][0] * rs + sa0, a1 = acc[ai][0][m][1] * rs + sa1, b0 = acc[ai][1][m][0] * rs + sb0, b1 = acc[ai][1][m][1] * rs + sb1;
                    u32x4 w; w.x = cvt_pk_bf16(silu_f(a0[0]) * b0[0], silu_f(a0[1]) * b0[1]); w.y = cvt_pk_bf16(silu_f(a0[2]) * b0[2], silu_f(a0[3]) * b0[3]);
                    w.z = cvt_pk_bf16(silu_f(a1[0]) * b1[0], silu_f(a1[1]) * b1[1]); w.w = cvt_pk_bf16(silu_f(a1[2]) * b1[2], silu_f(a1[3]) * b1[3]);
                    *(u32x4*)rowp = w; }
        } else {
            const int sec = u.pn >> 2; const int row0 = u.pm * BM + wr * 64 + fr, col0 = (u.pn & 3) * BM + wc * 32 + 8 * fq;
            bf16_t* base = proj + (size_t)sec * SECE;
            float rs[2][4];
#pragma unroll
            for (int ai = 0; ai < 2; ++ai)
#pragma unroll
                for (int m = 0; m < 4; ++m) rs[ai][m] = __builtin_amdgcn_rsqf((float)(*(const LAS long long*)(lx + (wr * 64 + fr + ai * HALF + m * 16) * 8)) * (1.0f / (1048576.0f * 1024.0f)) + EPS);
#pragma unroll
            for (int bj = 0; bj < 2; ++bj) {
                const LAS float* sp = (const LAS float*)(lx + 2048) + wc * 32 + 8 * fq + bj * HALF;
                const f32x4 sh0 = *(const LAS f32x4*)sp, sh1 = *(const LAS f32x4*)(sp + 4);
                f32x4 lb0 = (f32x4){0.f, 0.f, 0.f, 0.f}, lb1 = lb0;
                if (sec == 1 || sec == 2) { const float* lp = lbtab + (sec - 1) * 1024 + col0 + bj * HALF; lb0 = *(const f32x4*)lp; lb1 = *(const f32x4*)(lp + 4); }
#pragma unroll
                for (int ai = 0; ai < 2; ++ai)
#pragma unroll
                    for (int m = 0; m < 4; ++m) { bf16_t* rowp = base + (size_t)(row0 + ai * HALF + m * 16) * 1024 + col0;
                        f32x4 v0 = acc[ai][bj][m][0] * rs[ai][m] + sh0, v1 = acc[ai][bj][m][1] * rs[ai][m] + sh1;
                        if (sec == 0 || sec == 4) {
#pragma unroll
                            for (int j = 0; j < 4; ++j) { v0[j] = silu_f(v0[j]); v1[j] = silu_f(v1[j]); }
                        } else if (sec == 1 || sec == 2) {
#pragma unroll
                            for (int j = 0; j < 4; ++j) {
                                v0[j] = lb0[j] * __builtin_amdgcn_rcpf(1.0f + __expf(v0[j]));
                                v1[j] = lb1[j] * __builtin_amdgcn_rcpf(1.0f + __expf(v1[j])); }
                        }
                        u32x4 w; w.x = cvt_pk_bf16(v0[0], v0[1]); w.y = cvt_pk_bf16(v0[2], v0[3]); w.z = cvt_pk_bf16(v1[0], v1[1]); w.w = cvt_pk_bf16(v1[2], v1[3]);
                        *(u32x4*)(rowp + bj * HALF) = w; }
            }
        }
    }
};

template <class EpiT> __device__ __forceinline__ void gemm_phase(LAS unsigned char* lds, const bf16_t* gA, const bf16_t* gBt, int M, int N, int K, const StaticOrder& S, const EpiT& E) {
    const int tid = threadIdx.x, wid = __builtin_amdgcn_readfirstlane(tid >> 6), lane = tid & 63, wr = wid >> 2, wc = wid & 3, fr = lane & 15, fq = lane >> 4;
    const int nt = K / BK;
    unsigned voffA[2], voffB[2];
#pragma unroll
    for (int i = 0; i < 2; ++i) { int R, C; stage_rc(tid * 16 + i * 8192, R, C); const int Rb = EpiT::perm ? ((R & ~31) + perm32(R & 31)) : R;
        voffA[i] = (unsigned)(R * K + C) * 2u; voffB[i] = (unsigned)(Rb * K + C) * 2u; }
    const size_t kstep = (size_t)(BK * 2);
    const size_t hstep = (size_t)HALF * K * 2;
    const size_t tstep = 2 * hstep;
    const unsigned ldsw = (unsigned)wid * 1024u;
    const int aoff = lds_byte(wr * 64 + fr, fq * 8), boff = lds_byte(wc * 32 + fr, fq * 8);
#define PG8_SA(b, h) (((b) * 2 + (h)) * HTB)
#define PG8_SB(b, h) ((4 + (b) * 2 + (h)) * HTB)
#define PG8_STAGE(bufoff, gbase, voff) do { _Pragma("unroll") for (int _i = 0; _i < 2; ++_i) \
        __builtin_amdgcn_global_load_lds((const unsigned*)((const char*)(gbase) + (voff)[_i]), (LAS unsigned*)(lds + (bufoff) + ldsw + _i * 8192), 16, 0, 0); } while (0)
#define PG8_LDA(dst, b, h) do { _Pragma("unroll") for (int m = 0; m < 4; ++m) _Pragma("unroll") for (int k = 0; k < 2; ++k) dst[m][k] = *(const LAS bf16x8*)(lds + PG8_SA(b, h) + aoff + m * 2048 + k * 1024); } while (0)
#define PG8_LDB(dst, b, h) do { _Pragma("unroll") for (int n = 0; n < 2; ++n) _Pragma("unroll") for (int k = 0; k < 2; ++k) dst[n][k] = *(const LAS bf16x8*)(lds + PG8_SB(b, h) + boff + n * 2048 + k * 1024); } while (0)
#define PG8_MMA(ai, bj, At, Bt) do { __builtin_amdgcn_s_setprio(1); _Pragma("unroll") for (int m = 0; m < 4; ++m) _Pragma("unroll") for (int n = 0; n < 2; ++n) _Pragma("unroll") for (int k = 0; k < 2; ++k) \
        acc[ai][bj][m][n] = __builtin_amdgcn_mfma_f32_16x16x32_bf16(Bt[n][k], At[m][k], acc[ai][bj][m][n], 0, 0, 0); __builtin_amdgcn_s_setprio(0); } while (0)
#define PG8_WAIT_V(n) asm volatile("s_waitcnt vmcnt(" #n ")" ::: "memory")
#define PG8_WAIT_L(n) asm volatile("s_waitcnt lgkmcnt(" #n ")" ::: "memory")
#define PG8_BAR __builtin_amdgcn_s_barrier()
#define PG8_SCHED __builtin_amdgcn_sched_barrier(0)
    Unit cur, nxt; int ui = 0;
    if (!S.next(0, cur)) return;
    f32x4 acc[2][2][4][2];
#pragma unroll
    for (int a = 0; a < 2; ++a)
#pragma unroll
        for (int b = 0; b < 2; ++b)
#pragma unroll
            for (int m = 0; m < 4; ++m)
#pragma unroll
                for (int n = 0; n < 2; ++n) acc[a][b][m][n] = (f32x4){0.f, 0.f, 0.f, 0.f};
    bf16x8 At[4][2], B0[2][2], B1[2][2];
    const char* cA = (const char*)gA + (size_t)cur.pm * tstep; const char* cB = (const char*)gBt + (size_t)cur.pn * tstep;
    E.pre(lds + XOFF, cur, wid, lane);
    PG8_STAGE(PG8_SB(0, 0), cB, voffB); PG8_STAGE(PG8_SA(0, 0), cA, voffA); PG8_STAGE(PG8_SB(0, 1), cB + hstep, voffB); PG8_STAGE(PG8_SA(0, 1), cA + hstep, voffA);
    if (wr == 1) PG8_BAR;
    PG8_WAIT_V(4); PG8_BAR;
    PG8_STAGE(PG8_SB(1, 0), cB + kstep, voffB); PG8_STAGE(PG8_SA(1, 0), cA + kstep, voffA); PG8_STAGE(PG8_SB(1, 1), cB + hstep + kstep, voffB);
    PG8_WAIT_V(6); PG8_BAR;
    for (;;) {
        const bool has_next = S.next(ui + 1, nxt);
        const char* nA = has_next ? (const char*)gA + (size_t)nxt.pm * tstep : cA; const char* nB = has_next ? (const char*)gBt + (size_t)nxt.pn * tstep : cB;
        for (int t = 0; t < nt; t += 2) {
            const bool last = (t == nt - 2);
            const char* a1 = cA + (size_t)(t + 1) * kstep;
            const char* a2 = last ? nA : cA + (size_t)(t + 2) * kstep; const char* b2 = last ? nB : cB + (size_t)(t + 2) * kstep;
            const char* a3 = a2 + kstep; const char* b3 = b2 + kstep;
            PG8_LDB(B0, 0, 0); PG8_SCHED; PG8_LDA(At, 0, 0); PG8_STAGE(PG8_SA(1, 1), a1 + hstep, voffA);
            PG8_WAIT_L(8); PG8_BAR; PG8_WAIT_L(0); PG8_MMA(0, 0, At, B0); PG8_BAR; PG8_SCHED;
            PG8_LDB(B1, 0, 1); PG8_STAGE(PG8_SB(0, 0), b2, voffB);
            PG8_BAR; PG8_WAIT_L(0); PG8_MMA(0, 1, At, B1); PG8_BAR;
            PG8_LDA(At, 0, 1); PG8_STAGE(PG8_SA(0, 0), a2, voffA);
            PG8_BAR; PG8_WAIT_L(0); PG8_MMA(1, 0, At, B0); PG8_BAR; PG8_SCHED;
            PG8_STAGE(PG8_SB(0, 1), b2 + hstep, voffB);
            PG8_WAIT_V(6); PG8_BAR; PG8_MMA(1, 1, At, B1); PG8_BAR;
            PG8_LDB(B0, 1, 0); PG8_SCHED; PG8_LDA(At, 1, 0); PG8_STAGE(PG8_SA(0, 1), a2 + hstep, voffA);
            PG8_WAIT_L(8); PG8_BAR; PG8_WAIT_L(0); PG8_MMA(0, 0, At, B0); PG8_BAR; PG8_SCHED;
            PG8_LDB(B1, 1, 1); PG8_STAGE(PG8_SB(1, 0), b3, voffB);
            PG8_BAR; PG8_WAIT_L(0); PG8_MMA(0, 1, At, B1); PG8_BAR;
            PG8_LDA(At, 1, 1); PG8_STAGE(PG8_SA(1, 0), a3, voffA);
            PG8_BAR; PG8_WAIT_L(0); PG8_MMA(1, 0, At, B0); PG8_BAR; PG8_SCHED;
            PG8_STAGE(PG8_SB(1, 1), b3 + hstep, voffB);
            PG8_WAIT_V(6); PG8_BAR; PG8_MMA(1, 1, At, B1); PG8_BAR;
        }
        E(acc, cur, wr, wc, fr, fq, lds + XOFF + (ui & 1) * 3072);
        if (!has_next) break;
        E.pre(lds + XOFF + ((ui + 1) & 1) * 3072, nxt, wid, lane);
#pragma unroll
        for (int a = 0; a < 2; ++a)
#pragma unroll
            for (int b = 0; b < 2; ++b)
#pragma unroll
                for (int m = 0; m < 4; ++m)
#pragma unroll
                    for (int n = 0; n < 2; ++n) acc[a][b][m][n] = (f32x4){0.f, 0.f, 0.f, 0.f};
        cur = nxt; cA = nA; cB = nB; ++ui;
    }
    PG8_WAIT_V(0);
    if (wr == 0) PG8_BAR;
    PG8_BAR;
#undef PG8_SA
#undef PG8_SB
#undef PG8_STAGE
#undef PG8_LDA
#undef PG8_LDB
#undef PG8_MMA
#undef PG8_WAIT_V
#undef PG8_WAIT_L
#undef PG8_BAR
#undef PG8_SCHED
}

__device__ __forceinline__ void transpose_item(const float* W, int K, int N, bf16_t* WT, int dest_row0, int k0, int n0, LAS float* scr, int lane) {
#pragma unroll 8
    for (int i = 0; i < 32; ++i) { const int kk = 2 * i + (lane >> 5); scr[kk * 33 + (lane & 31)] = W[(size_t)(k0 + kk) * N + n0 + (lane & 31)]; }
    LDS_WAIT();
    const int c = lane & 7;
#pragma unroll
    for (int j = 0; j < 4; ++j) { const int n = (lane >> 3) + 8 * j; const LAS float* s = scr + (8 * c) * 33 + n;
        u32x4 o; o.x = cvt_pk_bf16(s[0 * 33], s[1 * 33]); o.y = cvt_pk_bf16(s[2 * 33], s[3 * 33]); o.z = cvt_pk_bf16(s[4 * 33], s[5 * 33]); o.w = cvt_pk_bf16(s[6 * 33], s[7 * 33]);
        *(u32x4*)(WT + (size_t)(dest_row0 + n) * K + k0 + 8 * c) = o; }
    LDS_WAIT();
}

__device__ __forceinline__ void prep_phase(const Params& p, LAS unsigned char* lds) {
    const int tid = threadIdx.x, lane = tid & 63, w = __builtin_amdgcn_readfirstlane(tid >> 6);
    unsigned char* ws = p.ws;
    {
        LAS float* sS = (LAS float*)(lds + 73728);
        LAS float* part = (LAS float*)(lds + 110592);
        float* mod = (float*)(ws + OFF_MOD);
        for (int it = blockIdx.x; it < 192; it += gridDim.x) {
            const int layer = it / 96, n0 = (it % 96) * 64;
            for (int idx = tid; idx < 9216; idx += 512) { const int j = idx >> 10, k = idx & 1023; const float v = j < 8 ? p.in[1][j * 1024 + k] : p.in[3][k]; sS[idx] = v / (1.0f + __expf(-v)); }
            __syncthreads();
            float a[9];
#pragma unroll
            for (int j = 0; j < 9; ++j) a[j] = 0.f;
            const float* wp = p.in[4] + ((size_t)layer * 1024 + w * 128) * 6144 + n0 + lane;
#pragma unroll 8
            for (int kk = 0; kk < 128; ++kk) { const float wv = wp[(size_t)kk * 6144];
#pragma unroll
                for (int j = 0; j < 9; ++j) a[j] += sS[j * 1024 + w * 128 + kk] * wv; }
#pragma unroll
            for (int j = 0; j < 9; ++j) part[(w * 9 + j) * 64 + lane] = a[j];
            __syncthreads();
            for (int idx = tid; idx < 576; idx += 512) { const int j = idx >> 6, l = idx & 63; float s = p.in[5][layer * 6144 + n0 + l];
#pragma unroll
                for (int ww = 0; ww < 8; ++ww) s += part[(ww * 9 + j) * 64 + l];
                mod[(layer * 9 + j) * 6144 + n0 + l] = s; }
            __syncthreads();
        }
    }
    {
        LAS float* scr = (LAS float*)(lds + w * 8448);
        const int gw = blockIdx.x * 8 + w, NGW = gridDim.x * 8;
        for (int it = gw; it < 16128; it += NGW) {
            int r = it; const float* W; bf16_t* WT; int K, N, swz = 0;
            if (r < 3072) { W = p.in[8]; WT = (bf16_t*)(ws + W_GMIN); K = 1024; N = 6144; }
            else if ((r -= 3072) < 1536) { W = p.in[14]; WT = (bf16_t*)(ws + W_GMOUT); K = 3072; N = 1024; }
            else if ((r -= 1536) < 2560) { W = p.in[15]; WT = (bf16_t*)(ws + W_HGIN); K = 1024; N = 5120; }
            else if ((r -= 2560) < 512) { W = p.in[18]; WT = (bf16_t*)(ws + W_HGOUT); K = 1024; N = 1024; }
            else if ((r -= 512) < 5632) { const int l = r / 2816; r -= l * 2816; W = p.in[19] + (size_t)l * 1024 * 5632; WT = (bf16_t*)(ws + W_FFIN) + (size_t)l * 5632 * 1024; K = 1024; N = 5632; swz = 1; }
            else { r -= 5632; const int l = r / 1408; r -= l * 1408; W = p.in[20] + (size_t)l * 2816 * 1024; WT = (bf16_t*)(ws + W_FFOUT) + (size_t)l * 1024 * 2816; K = 2816; N = 1024; }
            const int nblk = N / 32, kb = r / nblk, nb = r % nblk, k0 = 64 * kb, n0 = 32 * nb;
            int dest = n0;
            if (swz) { if (n0 < 2816) dest = (n0 >> 7) * 256 + (n0 & 127); else { const int j = n0 - 2816; dest = (j >> 7) * 256 + 128 + (j & 127); } }
            transpose_item(W, K, N, WT, dest, k0, n0, scr, lane);
        }
    }
    const int gt = blockIdx.x * 512 + tid, NT = gridDim.x * 512;
    { bf16_t* wsb = (bf16_t*)(ws + W_WS); for (int i = gt; i < 65536; i += NT) { const float a = p.in[12][2 * i], b = p.in[12][2 * i + 1]; ((unsigned*)wsb)[i] = cvt_pk_bf16(a, b); } }
    { unsigned long long* st = (unsigned long long*)(ws + OFF_STATS); for (int i = gt; i < MALL * 2; i += NT) st[i] = 0ull; }
    { unsigned long long* st = (unsigned long long*)(ws + OFF_SS); for (int i = gt; i < MALL * 3; i += NT) st[i] = 0ull; }
    { float* pos = (float*)(ws + OFF_POS); for (int i = gt; i < 192 * 512; i += NT) { const int pp = i >> 9, j = i & 511; const float ps = (float)(pp < 128 ? pp : pp - 128);
            const float om = expf(-(float)(j & 255) * (9.210340371976184f / 256.0f)); const float ang = ps * om; pos[i] = j < 256 ? sinf(ang) : cosf(ang); } }
    { float* lb = (float*)(ws + OFF_LB); for (int i = gt; i < 2048; i += NT) { const float l0 = p.in[16][i], l1 = p.in[16][2048 + i]; lb[i] = 1.0f - 1.0f / (1.0f + expf(l0 - l1)); } }
}

__device__ __forceinline__ void modrms_phase(const Params& p, int layer, int which, int nrows, bool first) {
    const int lane = threadIdx.x & 63, w = __builtin_amdgcn_readfirstlane(threadIdx.x >> 6);
    const int gw = blockIdx.x * 8 + w, NGW = gridDim.x * 8;
    const float* nw = p.in[which ? 7 : 6] + layer * 1024;
    const float* modl = (const float*)(p.ws + OFF_MOD) + layer * 9 * 6144 + (which ? 3 : 0) * 1024;
    const float* pos = (const float*)(p.ws + OFF_POS);
    bf16_t* H = (bf16_t*)(p.ws + OFF_H);
    float* xc = (float*)(p.ws + OFF_XC);
    for (int row0 = gw; row0 < nrows; row0 += 2 * NGW) {
        f32x4 v[2][4];
#pragma unroll
        for (int r = 0; r < 2; ++r) { const int row = row0 + r * NGW;
            if (row < nrows) {
                float* xp = row < MLAT ? p.out + (size_t)row * 1024 : xc + (size_t)(row - MLAT) * 1024;
                if (first) {
                    const float* src = row < MLAT ? p.in[0] + (size_t)row * 1024 : p.in[2] + (size_t)(row - MLAT) * 1024;
#pragma unroll
                    for (int j = 0; j < 4; ++j) v[r][j] = *(const f32x4*)(src + 256 * j + 4 * lane);
                    if (row < MLAT) { const int t = row & 8191, pr = t >> 6, pc = t & 63;
#pragma unroll
                        for (int j = 0; j < 4; ++j) { const float* pp = j < 2 ? pos + pr * 512 + 256 * j + 4 * lane : pos + (128 + pc) * 512 + 256 * (j - 2) + 4 * lane; v[r][j] = v[r][j] + *(const f32x4*)pp; } }
                } else {
#pragma unroll
                    for (int j = 0; j < 4; ++j) v[r][j] = *(const f32x4*)(xp + 256 * j + 4 * lane);
                }
            } else {
#pragma unroll
                for (int j = 0; j < 4; ++j) v[r][j] = (f32x4){0.f, 0.f, 0.f, 0.f};
            } }
#pragma unroll
        for (int r = 0; r < 2; ++r) { const int row = row0 + r * NGW;
            if (row < nrows) {
                const int bi = row < MLAT ? (row >> 13) : 8;
                float* xp = row < MLAT ? p.out + (size_t)row * 1024 : xc + (size_t)(row - MLAT) * 1024;
                if (first) {
                    if (row < MLAT) { bf16_t* xb = (bf16_t*)p.out + (size_t)row * 2048;
#pragma unroll
                        for (int j = 0; j < 4; ++j) { u32x2 o; o.x = cvt_pk_bf16(v[r][j][0], v[r][j][1]); o.y = cvt_pk_bf16(v[r][j][2], v[r][j][3]); *(u32x2*)(xb + 256 * j + 4 * lane) = o; }
                    } else {
#pragma unroll
                        for (int j = 0; j < 4; ++j) *(f32x4*)(xp + 256 * j + 4 * lane) = v[r][j];
                    }
                }
                float ss = 0.f;
#pragma unroll
                for (int j = 0; j < 4; ++j) ss += (v[r][j][0] * v[r][j][0] + v[r][j][1] * v[r][j][1]) + (v[r][j][2] * v[r][j][2] + v[r][j][3] * v[r][j][3]);
                ss = wave_sum(ss);
                const float rstd = rsqrtf(ss * (1.0f / 1024.0f) + EPS);
                const float* sh = modl + bi * 6144; const float* sc = sh + 1024;
#pragma unroll
                for (int j = 0; j < 4; ++j) { const int c = 256 * j + 4 * lane; const f32x4 w4 = *(const f32x4*)(nw + c), s4 = *(const f32x4*)(sh + c), c4 = *(const f32x4*)(sc + c);
                    const f32x4 h = v[r][j] * rstd * w4 * (c4 + 1.0f) + s4; u32x2 o; o.x = cvt_pk_bf16(h[0], h[1]); o.y = cvt_pk_bf16(h[2], h[3]);
                    *(u32x2*)(H + (size_t)row * 1024 + c) = o; }
            } }
    }
}

__device__ __forceinline__ void tables_phase(const Params& p, LAS unsigned char* lds) {
    const int tid = threadIdx.x, lane = tid & 63, w = __builtin_amdgcn_readfirstlane(tid >> 6);
    unsigned char* ws = p.ws;
    const float* mod = (const float*)(ws + OFF_MOD);
    float* GN = (float*)(ws + OFF_GN); float* SHB = (float*)(ws + OFF_SHB);
    const int gt = blockIdx.x * 512 + tid, NT = gridDim.x * 512;
    for (int i = gt; i < 3 * 9216; i += NT) { const int n = i / 9216, r = i % 9216, b = r >> 10, k = r & 1023; const int layer = n == 0 ? 0 : 1, which = n == 1 ? 0 : 1;
        GN[i] = p.in[which ? 7 : 6][layer * 1024 + k] * (1.0f + mod[(layer * 9 + b) * 6144 + (which ? 4 : 1) * 1024 + k]); }
    LAS float* sS = (LAS float*)lds;
    for (int it = blockIdx.x; it < 256; it += gridDim.x) {
        int n, r0; const bf16_t* wt; const float* sh;
        if (it < 88) { n = 0; r0 = it * 64; wt = (const bf16_t*)(ws + W_FFIN) + (size_t)r0 * 1024; sh = mod + 3 * 1024; }
        else if (it < 168) { n = 1; r0 = (it - 88) * 64; wt = (const bf16_t*)(ws + W_HGIN) + (size_t)r0 * 1024; sh = mod + 9 * 6144; }
        else { n = 2; r0 = (it - 168) * 64; wt = (const bf16_t*)(ws + W_FFIN) + (size_t)(5632 + r0) * 1024; sh = mod + 9 * 6144 + 3 * 1024; }
        __syncthreads();
        for (int i = tid; i < 9216; i += 512) sS[i] = sh[(i >> 10) * 6144 + (i & 1023)];
        __syncthreads();
        u32x4 wv[8][2];
#pragma unroll
        for (int j = 0; j < 8; ++j) { const bf16_t* wr_ = wt + (size_t)(w * 8 + j) * 1024 + lane * 16; wv[j][0] = *(const u32x4*)wr_; wv[j][1] = *(const u32x4*)(wr_ + 8); }
        for (int b = 0; b < 9; ++b) {
            f32x4 s4[4];
#pragma unroll
            for (int i = 0; i < 4; ++i) s4[i] = *(const LAS f32x4*)(sS + b * 1024 + lane * 16 + 4 * i);
#pragma unroll
            for (int j = 0; j < 8; ++j) { float d = 0.f;
#pragma unroll
                for (int i = 0; i < 4; ++i) { const unsigned a0 = wv[j][i >> 1][(i & 1) * 2], a1 = wv[j][i >> 1][(i & 1) * 2 + 1];
                    d += (bflo(a0) * s4[i][0] + bfhi(a0) * s4[i][1]) + (bflo(a1) * s4[i][2] + bfhi(a1) * s4[i][3]); }
                d = wave_sum(d);
                if (lane == 0) SHB[(n * 9 + b) * 5632 + r0 + w * 8 + j] = d; }
        }
    }
}

__device__ __forceinline__ void final_phase(const Params& p) {
    const int lane = threadIdx.x & 63, w = __builtin_amdgcn_readfirstlane(threadIdx.x >> 6);
    const int gw = blockIdx.x * 8 + w, NGW = gridDim.x * 8;
    const float* fw = p.in[21];
    f32x4 w4[4];
#pragma unroll
    for (int j = 0; j < 4; ++j) w4[j] = *(const f32x4*)(fw + lane * 16 + 4 * j);
    for (int row0 = gw; row0 < MLAT; row0 += 2 * NGW) {
        u32x4 a[2][2];
#pragma unroll
        for (int r = 0; r < 2; ++r) { const int row = row0 + r * NGW; const bf16_t* xb = (const bf16_t*)p.out + (size_t)(row < MLAT ? row : row0) * 2048 + lane * 16;
            a[r][0] = *(const u32x4*)xb; a[r][1] = *(const u32x4*)(xb + 8); }
        asm volatile("s_waitcnt vmcnt(0)" ::: "memory");
#pragma unroll
        for (int r = 0; r < 2; ++r) { const int row = row0 + r * NGW;
            if (row < MLAT) {
                f32x4 v[4];
                v[0] = (f32x4){bflo(a[r][0].x), bfhi(a[r][0].x), bflo(a[r][0].y), bfhi(a[r][0].y)}; v[1] = (f32x4){bflo(a[r][0].z), bfhi(a[r][0].z), bflo(a[r][0].w), bfhi(a[r][0].w)};
                v[2] = (f32x4){bflo(a[r][1].x), bfhi(a[r][1].x), bflo(a[r][1].y), bfhi(a[r][1].y)}; v[3] = (f32x4){bflo(a[r][1].z), bfhi(a[r][1].z), bflo(a[r][1].w), bfhi(a[r][1].w)};
                float ss = 0.f;
#pragma unroll
                for (int j = 0; j < 4; ++j) ss += (v[j][0] * v[j][0] + v[j][1] * v[j][1]) + (v[j][2] * v[j][2] + v[j][3] * v[j][3]);
                ss = wave_sum(ss); const float rstd = rsqrtf(ss * (1.0f / 1024.0f) + EPS);
                float* op = p.out + (size_t)row * 1024 + lane * 16;
#pragma unroll
                for (int j = 0; j < 4; ++j) *(f32x4*)(op + 4 * j) = v[j] * rstd * w4[j];
            } }
    }
}

__device__ __forceinline__ void spatial_phase(const Params& p, LAS unsigned char* lds) {
    const int tid = threadIdx.x, lane = tid & 63, w = __builtin_amdgcn_readfirstlane(tid >> 6), fr = lane & 15, fq = lane >> 4, wp = w >> 1, wcn = w & 1;
    bf16_t* U = (bf16_t*)(p.ws + OFF_U); const bf16_t* V = (const bf16_t*)(p.ws + OFF_V);
    const long long* stats = (const long long*)(p.ws + OFF_STATS); const bf16_t* Wsb = (const bf16_t*)(p.ws + W_WS);
    const float* lng = p.in[10]; const float* lnb = p.in[11]; const float* bs = p.in[13];
    LAS unsigned* VT = (LAS unsigned*)lds;
    const int ck = tid & 15, c = ck * 8, qp0 = tid >> 4;
    constexpr int NITEM = 528 * 24;
    u32x4 va[2], vb[2]; long long st[2][4]; f32x4 g0, g1, b0, b1;
    int item = blockIdx.x;
    if (item < NITEM) { const int ritem = NITEM - 1 - item; const int ci = ritem / 24, sl = ritem % 24, r0 = ci * 128, c0 = sl * 128;
#pragma unroll
        for (int it = 0; it < 2; ++it) { const int q = (qp0 + it * 32) * 2; va[it] = *(const u32x4*)(V + (size_t)(r0 + q) * 3072 + c0 + c); vb[it] = *(const u32x4*)(V + (size_t)(r0 + q + 1) * 3072 + c0 + c);
            const long long* stp = stats + 2 * (r0 + q); st[it][0] = stp[0]; st[it][1] = stp[1]; st[it][2] = stp[2]; st[it][3] = stp[3]; }
        g0 = *(const f32x4*)(lng + c0 + c); g1 = *(const f32x4*)(lng + c0 + c + 4); b0 = *(const f32x4*)(lnb + c0 + c); b1 = *(const f32x4*)(lnb + c0 + c + 4); }
    for (; item < NITEM; item += gridDim.x) {
        const int ritem = NITEM - 1 - item;
        const int ci = ritem / 24, sl = ritem % 24, g = sl / 3, r0 = ci * 128, c0 = sl * 128;
        bf16x8 Wf[2][4];
#pragma unroll
        for (int rt = 0; rt < 2; ++rt)
#pragma unroll
            for (int ks = 0; ks < 4; ++ks) Wf[rt][ks] = *(const bf16x8*)(Wsb + ((size_t)(g * 128 + wp * 32 + rt * 16 + fr) * 128 + ks * 32 + fq * 8));
        u32x4 uu[2][2]; float bsv[2];
#pragma unroll
        for (int rt = 0; rt < 2; ++rt) { const int pr = wp * 32 + rt * 16 + fr; bsv[rt] = bs[g * 128 + pr];
#pragma unroll
            for (int cp2 = 0; cp2 < 2; ++cp2) uu[rt][cp2] = *(const u32x4*)(U + (size_t)(r0 + pr) * 3072 + c0 + wcn * 64 + cp2 * 32 + fq * 8); }
#pragma unroll
        for (int it = 0; it < 2; ++it) {
            const int qp = qp0 + it * 32;
            const float FX = 1.0f / (1048576.0f * 3072.0f);
            const float mu0 = (float)st[it][0] * FX, mu1 = (float)st[it][2] * FX;
            const float rs0 = __builtin_amdgcn_rsqf(fmaxf((float)st[it][1] * FX - mu0 * mu0, 0.f) + EPS), rs1 = __builtin_amdgcn_rsqf(fmaxf((float)st[it][3] * FX - mu1 * mu1, 0.f) + EPS);
            const float nm0 = -mu0 * rs0, nm1 = -mu1 * rs1;
#pragma unroll
            for (int i = 0; i < 8; ++i) {
                const unsigned wa = va[it][i >> 1], wb = vb[it][i >> 1];
                const float xa = (i & 1) ? bfhi(wa) : bflo(wa), xb = (i & 1) ? bfhi(wb) : bflo(wb);
                const float gg = i < 4 ? g0[i & 3] : g1[i & 3], bb = i < 4 ? b0[i & 3] : b1[i & 3];
                VT[(c + i) * 68 + (qp ^ (4 * ck))] = cvt_pk_bf16((xa * rs0 + nm0) * gg + bb, (xb * rs1 + nm1) * gg + bb);
            }
        }
        __syncthreads();
        { const int nitem = item + gridDim.x;
            if (nitem < NITEM) { const int rn = NITEM - 1 - nitem; const int nci = rn / 24, nsl = rn % 24, nr0 = nci * 128, nc0 = nsl * 128;
#pragma unroll
                for (int it = 0; it < 2; ++it) { const int q = (qp0 + it * 32) * 2; va[it] = *(const u32x4*)(V + (size_t)(nr0 + q) * 3072 + nc0 + c); vb[it] = *(const u32x4*)(V + (size_t)(nr0 + q + 1) * 3072 + nc0 + c);
                    const long long* stp = stats + 2 * (nr0 + q); st[it][0] = stp[0]; st[it][1] = stp[1]; st[it][2] = stp[2]; st[it][3] = stp[3]; }
                g0 = *(const f32x4*)(lng + nc0 + c); g1 = *(const f32x4*)(lng + nc0 + c + 4); b0 = *(const f32x4*)(lnb + nc0 + c); b1 = *(const f32x4*)(lnb + nc0 + c + 4); } }
        f32x4 acc[2][4];
#pragma unroll
        for (int rt = 0; rt < 2; ++rt)
#pragma unroll
            for (int ct = 0; ct < 4; ++ct) acc[rt][ct] = (f32x4){0.f, 0.f, 0.f, 0.f};
#pragma unroll
        for (int ks = 0; ks < 4; ++ks)
#pragma unroll
            for (int ct = 0; ct < 4; ++ct) {
                const int crow = wcn * 64 + (ct >> 1) * 32 + 8 * (fr >> 2) + 4 * (ct & 1) + (fr & 3);
                const bf16x8 Bf = *(const LAS bf16x8*)(lds + crow * 272 + (((ks * 16 + fq * 4) ^ (4 * ((crow >> 3) & 15))) * 4));
#pragma unroll
                for (int rt = 0; rt < 2; ++rt) acc[rt][ct] = MFMA16(Bf, Wf[rt][ks], acc[rt][ct]);
            }
#pragma unroll
        for (int rt = 0; rt < 2; ++rt) { const int pr = wp * 32 + rt * 16 + fr;
#pragma unroll
            for (int cp2 = 0; cp2 < 2; ++cp2) { bf16_t* up = U + (size_t)(r0 + pr) * 3072 + c0 + wcn * 64 + cp2 * 32 + fq * 8; const u32x4 u4 = uu[rt][cp2];
                const f32x2 ga = gelu_pk((f32x2){bflo(u4.x), bfhi(u4.x)}), gb = gelu_pk((f32x2){bflo(u4.y), bfhi(u4.y)}), gc = gelu_pk((f32x2){bflo(u4.z), bfhi(u4.z)}), gd = gelu_pk((f32x2){bflo(u4.w), bfhi(u4.w)});
                const f32x4 a0 = acc[rt][2 * cp2] + bsv[rt], a1 = acc[rt][2 * cp2 + 1] + bsv[rt];
                u32x4 o; o.x = cvt_pk_bf16(a0[0] * ga.x, a0[1] * ga.y); o.y = cvt_pk_bf16(a0[2] * gb.x, a0[3] * gb.y); o.z = cvt_pk_bf16(a1[0] * gc.x, a1[1] * gc.y); o.w = cvt_pk_bf16(a1[2] * gd.x, a1[3] * gd.y);
                *(u32x4*)up = o; } }
        __syncthreads();
    }
}

__device__ __forceinline__ int scan_base(int c, int b, int dir) {
    return c < 4 ? (MLAT + b * 256 + (dir ? 255 - c * 64 : c * 64)) : (b * 8192 + (dir ? 8191 - (c - 4) * 64 : (c - 4) * 64));
}
__device__ __forceinline__ void scan_phase(const Params& p, LAS unsigned char* lds) {
    const int tid = threadIdx.x, lane = tid & 63, w = __builtin_amdgcn_readfirstlane(tid >> 6), fr = lane & 15, fq = lane >> 4;
    constexpr int SET = 62976, oKI = 17408, oKDT = 34816, oVT = 53248, oDD = 62464;
    LAS unsigned char* ATT = lds + 125952; LAS unsigned char* ST = lds + 135168; LAS float* SEGT = (LAS float*)(lds + 152576);
    const bf16_t* sec0 = (const bf16_t*)(p.ws + OFF_U);
    bf16_t* OF = (bf16_t*)(p.ws + OFF_V + 2 * SEC); bf16_t* OB = (bf16_t*)(p.ws + OFF_H);
    const int cp = tid & 63, seg = tid >> 6, dvv = tid & 63, ts = tid >> 6;
#define SCAN_LOAD(cc) do { const int _b = scan_base((cc), b, dir); _Pragma("unroll") for (int i = 0; i < 8; ++i) { const int row = _b + sgn * (seg * 8 + i); \
        rq[i] = *(const unsigned*)(Qp + (size_t)row * 1024); rk[i] = *(const unsigned*)(Kp + (size_t)row * 1024); rv[i] = Vp[(size_t)row * 1024]; } } while (0)
#define SCAN_UNPACK() do { _Pragma("unroll") for (int i = 0; i < 8; ++i) { q0[i] = bflo(rq[i]); q1[i] = bfhi(rq[i]); k0[i] = bflo(rk[i]); k1[i] = bfhi(rk[i]); } \
        vpk.x = (unsigned)rv[0] | ((unsigned)rv[1] << 16); vpk.y = (unsigned)rv[2] | ((unsigned)rv[3] << 16); vpk.z = (unsigned)rv[4] | ((unsigned)rv[5] << 16); vpk.w = (unsigned)rv[6] | ((unsigned)rv[7] << 16); } while (0)
#define SCAN_P1() do { float r0 = 1.f, r1 = 1.f; _Pragma("unroll") for (int i = 0; i < 8; ++i) { r0 *= (1.0f - k0[i]); r1 *= (1.0f - k1[i]); c0[i] = r0; c1[i] = r1; } \
        *(LAS f32x2*)(SEGT + seg * 128 + 2 * cp) = (f32x2){r0, r1}; } while (0)
#define SCAN_P2(so) do { LAS unsigned char* _QD = lds + (so); LAS unsigned char* _KI = _QD + oKI; LAS unsigned char* _KDT = _QD + oKDT; LAS unsigned char* _VT = _QD + oVT; LAS float* _DD = (LAS float*)(_QD + oDD); \
        float of0 = 1.f, of1 = 1.f, tt0 = 1.f, tt1 = 1.f; \
        _Pragma("unroll") for (int s_ = 0; s_ < 8; ++s_) { const f32x2 t = *(const LAS f32x2*)(SEGT + s_ * 128 + 2 * cp); tt0 *= t.x; tt1 *= t.y; of0 *= (s_ < seg) ? t.x : 1.f; of1 *= (s_ < seg) ? t.y : 1.f; } \
        unsigned kda[4], kdb[4]; \
        _Pragma("unroll") for (int i = 0; i < 8; i += 2) { float kd0[2], kd1[2]; \
            _Pragma("unroll") for (int e = 0; e < 2; ++e) { const float e0 = of0 * c0[i + e], e1 = of1 * c1[i + e]; const float r0 = __builtin_amdgcn_rcpf(e0), r1 = __builtin_amdgcn_rcpf(e1); const int t = seg * 8 + i + e; \
                *(LAS unsigned*)(_QD + (t * 136 + 2 * cp) * 2) = cvt_pk_bf16(q0[i + e] * e0, q1[i + e] * e1); \
                *(LAS unsigned*)(_KI + (t * 136 + 2 * cp) * 2) = cvt_pk_bf16(k0[i + e] * r0, k1[i + e] * r1); \
                kd0[e] = k0[i + e] * (tt0 * r0); kd1[e] = k1[i + e] * (tt1 * r1); } \
            kda[i >> 1] = cvt_pk_bf16(kd0[0], kd0[1]); kdb[i >> 1] = cvt_pk_bf16(kd1[0], kd1[1]); } \
        *(LAS u32x4*)(_KDT + ((2 * cp) * 72 + seg * 8) * 2) = (u32x4){kda[0], kda[1], kda[2], kda[3]}; \
        *(LAS u32x4*)(_KDT + ((2 * cp + 1) * 72 + seg * 8) * 2) = (u32x4){kdb[0], kdb[1], kdb[2], kdb[3]}; \
        if (seg == 0) *(LAS f32x2*)(_DD + 2 * cp) = (f32x2){tt0, tt1}; \
        *(LAS u32x4*)(_VT + (dvv * 72 + ts * 8) * 2) = vpk; } while (0)
    for (int chain = blockIdx.x; chain < 256; chain += gridDim.x) {
        const int vh = chain & 1, dir = (chain >> 1) & 1, h = (chain >> 2) & 7, b = chain >> 5;
        const bf16_t* Qp = sec0 + h * 128 + 2 * cp;
        const bf16_t* Kp = sec0 + (size_t)(1 + dir) * SECE + h * 128 + 2 * cp;
        const bf16_t* Vp = sec0 + (size_t)3 * SECE + h * 128 + vh * 64 + dvv;
        bf16_t* Op = (dir ? OB : OF) + h * 128 + vh * 64;
        const int sgn = dir ? -1 : 1;
        f32x4 S[4];
#pragma unroll
        for (int i = 0; i < 4; ++i) S[i] = (f32x4){0.f, 0.f, 0.f, 0.f};
        for (int i = tid; i < 4352; i += 512) ((LAS unsigned*)ST)[i] = 0u;
        unsigned rq[8], rk[8]; unsigned short rv[8];
        float q0[8], q1[8], k0[8], k1[8], c0[8], c1[8]; u32x4 vpk;
        SCAN_LOAD(0);
        SCAN_UNPACK();
        SCAN_LOAD(1);
        SCAN_P1();
        __syncthreads();
        SCAN_P2(0);
        __syncthreads();
        for (int c = 0; c < 132; ++c) {
            const int base = scan_base(c, b, dir);
            const int so = (c & 1) * SET;
            LAS unsigned char* QD = lds + so; LAS unsigned char* KI = QD + oKI; LAS unsigned char* KDT = QD + oKDT; LAS unsigned char* VT = QD + oVT; LAS float* DD = (LAS float*)(QD + oDD);
            if (c > 0) {
#pragma unroll
                for (int dt = 0; dt < 4; ++dt) { u32x2 o; o.x = cvt_pk_bf16(S[dt][0], S[dt][1]); o.y = cvt_pk_bf16(S[dt][2], S[dt][3]);
                    *(LAS u32x2*)(ST + ((dt * 16 + fr) * 136 + w * 16 + fq * 4) * 2) = o; }
            }
            if (c + 1 < 132) { SCAN_UNPACK(); if (c + 2 < 132) SCAN_LOAD(c + 2); SCAN_P1(); }
            bf16x8 qf[4];
            { const int ti = w >> 1;
#pragma unroll
                for (int ks = 0; ks < 4; ++ks) qf[ks] = *(const LAS bf16x8*)(QD + ((ti * 16 + fr) * 136 + ks * 32 + fq * 8) * 2);
#pragma unroll
                for (int sj = 0; sj < 2; ++sj) { const int si = (w & 1) * 2 + sj; f32x4 a = (f32x4){0.f, 0.f, 0.f, 0.f};
                    if (si <= ti) {
#pragma unroll
                        for (int ks = 0; ks < 4; ++ks) { const bf16x8 X = *(const LAS bf16x8*)(KI + ((si * 16 + fr) * 136 + ks * 32 + fq * 8) * 2);
                            a = MFMA16(X, qf[ks], a); }
                        const int tg = ti * 16 + fr, sg = si * 16 + fq * 4;
#pragma unroll
                        for (int j = 0; j < 4; ++j) a[j] = (sg + j <= tg) ? a[j] : 0.f;
                    }
                    u32x2 o; o.x = cvt_pk_bf16(a[0], a[1]); o.y = cvt_pk_bf16(a[2], a[3]);
                    *(LAS u32x2*)(ATT + ((ti * 16 + fr) * 72 + si * 16 + fq * 4) * 2) = o; } }
            __syncthreads();
            if (c + 1 < 132) SCAN_P2(SET - so);
            { const int ti = w >> 1;
#pragma unroll
                for (int dj = 0; dj < 2; ++dj) { const int di = (w & 1) * 2 + dj; f32x4 a = (f32x4){0.f, 0.f, 0.f, 0.f};
#pragma unroll
                    for (int ks = 0; ks < 2; ++ks) { const bf16x8 X = *(const LAS bf16x8*)(VT + ((di * 16 + fr) * 72 + ks * 32 + fq * 8) * 2), Y = *(const LAS bf16x8*)(ATT + ((ti * 16 + fr) * 72 + ks * 32 + fq * 8) * 2);
                        a = MFMA16(X, Y, a); }
#pragma unroll
                    for (int ks = 0; ks < 4; ++ks) { const bf16x8 X = *(const LAS bf16x8*)(ST + ((di * 16 + fr) * 136 + ks * 32 + fq * 8) * 2);
                        a = MFMA16(X, qf[ks], a); }
                    if (c >= 4) { const int row = base + sgn * (ti * 16 + fr); u32x2 o; o.x = cvt_pk_bf16(a[0], a[1]); o.y = cvt_pk_bf16(a[2], a[3]);
                        *(u32x2*)(Op + (size_t)row * 1024 + di * 16 + fq * 4) = o; } } }
            { const f32x4 dd = *(const LAS f32x4*)(DD + w * 16 + fq * 4);
#pragma unroll
                for (int dt = 0; dt < 4; ++dt) { S[dt] = S[dt] * dd;
#pragma unroll
                    for (int ks = 0; ks < 2; ++ks) { const bf16x8 X = *(const LAS bf16x8*)(KDT + ((w * 16 + fr) * 72 + ks * 32 + fq * 8) * 2), Y = *(const LAS bf16x8*)(VT + ((dt * 16 + fr) * 72 + ks * 32 + fq * 8) * 2);
                        S[dt] = MFMA16(X, Y, S[dt]); } } }
            __syncthreads();
        }
    }
#undef SCAN_LOAD
#undef SCAN_UNPACK
#undef SCAN_P1
#undef SCAN_P2
}

__device__ __forceinline__ void readout_phase(const Params& p) {
    const int lane = threadIdx.x & 63, w = __builtin_amdgcn_readfirstlane(threadIdx.x >> 6);
    const int gw = blockIdx.x * 8 + w, NGW = gridDim.x * 8;
    const bf16_t* OF = (const bf16_t*)(p.ws + OFF_V + 2 * SEC); const bf16_t* OB = (const bf16_t*)(p.ws + OFF_H);
    const bf16_t* G = (const bf16_t*)(p.ws + OFF_U) + (size_t)4 * SECE; bf16_t* R = (bf16_t*)(p.ws + OFF_U);
    const float* nw = p.in[17];
    for (int row0 = gw; row0 < MLAT; row0 += 2 * NGW) {
        u32x4 a[2][2], b[2][2], g[2][2];
#pragma unroll
        for (int r = 0; r < 2; ++r) { const int row = row0 + r * NGW; const size_t o = (size_t)(row < MLAT ? row : row0) * 1024 + lane * 16;
#pragma unroll
            for (int i = 0; i < 2; ++i) { a[r][i] = *(const u32x4*)(OF + o + 8 * i); b[r][i] = *(const u32x4*)(OB + o + 8 * i); g[r][i] = *(const u32x4*)(G + o + 8 * i); } }
#pragma unroll
        for (int r = 0; r < 2; ++r) { const int row = row0 + r * NGW;
            if (row < MLAT) { const size_t o = (size_t)row * 1024 + lane * 16;
                float v[16]; float ss = 0.f;
#pragma unroll
                for (int i = 0; i < 8; ++i) { const unsigned wa = a[r][i >> 2][i & 3], wb = b[r][i >> 2][i & 3]; v[2 * i] = bflo(wa) + bflo(wb); v[2 * i + 1] = bfhi(wa) + bfhi(wb); ss += v[2 * i] * v[2 * i] + v[2 * i + 1] * v[2 * i + 1]; }
                ss += __shfl_xor(ss, 1); ss += __shfl_xor(ss, 2); ss += __shfl_xor(ss, 4);
                const float rstd = rsqrtf(ss * (1.0f / 128.0f) + EPS);
                u32x4 rr[2];
#pragma unroll
                for (int i = 0; i < 8; ++i) { const unsigned wg = g[r][i >> 2][i & 3]; const f32x2 n2 = *(const f32x2*)(nw + lane * 16 + 2 * i);
                    rr[i >> 2][i & 3] = cvt_pk_bf16(v[2 * i] * rstd * n2.x * bflo(wg), v[2 * i + 1] * rstd * n2.y * bfhi(wg)); }
                *(u32x4*)(R + o) = rr[0]; *(u32x4*)(R + o + 8) = rr[1]; } }
    }
}

#define XB_TMO      128
#define XB_XCNT(j)  (256  + 64 * (j))
#define XB_XSUB(j)  (1280 + 64 * (j))
#define XB_XGEN(j)  (2304 + 64 * (j))
#define XB_TOP      3328
#define XB_TOPGEN   3392
#define XB_SPIN_CAP (1u << 22)
__device__ __forceinline__ unsigned xb_ld(unsigned* p)              { return __hip_atomic_load(p, __ATOMIC_RELAXED, __HIP_MEMORY_SCOPE_AGENT); }
__device__ __forceinline__ unsigned xb_add(unsigned* p, unsigned v) { return __hip_atomic_fetch_add(p, v, __ATOMIC_RELAXED, __HIP_MEMORY_SCOPE_AGENT); }
__device__ __forceinline__ unsigned xb_xcc_id() { return (unsigned)__builtin_amdgcn_s_getreg((3 << 11) | 20) & 0xFu; }
#define XB_SPIN(cond, bar) do { unsigned _sp = 0; while (cond) { __builtin_amdgcn_s_sleep(1); \
    if ((++_sp & 255u) == 0u) { if (xb_ld(&(bar)[XB_TMO])) break; if (_sp > XB_SPIN_CAP) { atomicAdd(&(bar)[XB_TMO], 1u); break; } } } } while (0)
struct XcdBarrier { unsigned* bar; unsigned x; volatile LAS unsigned* st; };
__device__ __forceinline__ XcdBarrier xcd_barrier_post(unsigned* bar, volatile LAS unsigned* st) {
    XcdBarrier b; b.bar = bar; b.x = xb_xcc_id(); b.st = st;
    if (threadIdx.x == 0) (void)xb_add(&bar[XB_XCNT(b.x)], 1u);
    return b;
}
__device__ __forceinline__ void xcd_barrier_complete(unsigned* bar, unsigned x, unsigned& nloc, unsigned& nx) {
    const unsigned G = gridDim.x * gridDim.y * gridDim.z;
    unsigned sum, cnt, mine, sp = 0u;
    for (;;) {
        sum = 0u; cnt = 0u; mine = 0u;
#pragma unroll
        for (unsigned j = 0; j < 16; ++j) { const unsigned c = xb_ld(&bar[XB_XCNT(j)]); sum += c; cnt += (c > 0u) ? 1u : 0u; mine = (j == x) ? c : mine; }
        if (sum == G) break;
        __builtin_amdgcn_s_sleep(1);
        if ((++sp & 255u) == 0u) { if (xb_ld(&bar[XB_TMO])) break; if (sp > XB_SPIN_CAP) { atomicAdd(&bar[XB_TMO], 1u); break; } }
    }
    nloc = mine > 0u ? mine : 1u; nx = cnt > 0u ? cnt : 1u;
}
__device__ __forceinline__ void xcd_barrier(const XcdBarrier& b) {
    asm volatile("s_waitcnt vmcnt(0)" ::: "memory");
    __syncthreads();
    if (threadIdx.x == 0) {
        unsigned* bar = b.bar;
        __builtin_amdgcn_s_waitcnt(0);
        unsigned nloc = b.st[0], nx = b.st[1];
        if (nloc == 0u) { xcd_barrier_complete(bar, b.x, nloc, nx); b.st[0] = nloc; b.st[1] = nx; }
        const unsigned old = xb_add(&bar[XB_XSUB(b.x)], 1u);
        const unsigned gen = old / nloc;
        if (old + 1u == (gen + 1u) * nloc) {
            __builtin_amdgcn_fence(__ATOMIC_RELEASE, "agent");
            asm volatile("s_waitcnt vmcnt(0)" ::: "memory");
            const unsigned og = xb_add(&bar[XB_TOP], 1u);
            const unsigned tg = og / nx;
            if (og + 1u == (tg + 1u) * nx) xb_add(&bar[XB_TOPGEN], 1u);
            else XB_SPIN(xb_ld(&bar[XB_TOPGEN]) == tg, bar);
            __builtin_amdgcn_fence(__ATOMIC_ACQUIRE, "agent");
            xb_add(&bar[XB_XGEN(b.x)], 1u);
            asm volatile("s_waitcnt vmcnt(0)" ::: "memory");
        } else {
            XB_SPIN(xb_ld(&bar[XB_XGEN(b.x)]) == gen, bar);
            __builtin_amdgcn_fence(__ATOMIC_ACQUIRE, "agent");
            asm volatile("s_waitcnt vmcnt(0)" ::: "memory");
        }
    }
    __syncthreads();
}

__device__ __forceinline__ void ctx_gemm_phase(LAS unsigned char* lds, const bf16_t* A, const bf16_t* Wt, int K, const float* gate, const float* gn, unsigned long long* ssw, bf16_t* xg, float* xc) {
    const int tid = threadIdx.x, lane = tid & 63, w = __builtin_amdgcn_readfirstlane(tid >> 6), fr = lane & 15, fq = lane >> 4, wr = w >> 2, wc = w & 3;
    const int ns = K / 128;
    for (int t = blockIdx.x; t < 256; t += gridDim.x) {
        const int rt = t >> 3, ct = t & 7;
        const bf16_t* ag[2]; const bf16_t* bg[4]; int lofA[2], lofB[4];
#pragma unroll
        for (int q = 0; q < 2; ++q) { const int pz = tid + 512 * q, row = pz >> 4, c16 = pz & 15; ag[q] = A + (size_t)(rt * 64 + row) * K + c16 * 8; lofA[q] = row * 272 + c16 * 16; }
#pragma unroll
        for (int q = 0; q < 4; ++q) { const int pz = tid + 512 * q, row = pz >> 4, c16 = pz & 15; bg[q] = Wt + (size_t)(ct * 128 + row) * K + c16 * 8; lofB[q] = 17408 + row * 272 + c16 * 16; }
        f32x4 acc[2][2];
#pragma unroll
        for (int i = 0; i < 2; ++i)
#pragma unroll
            for (int j = 0; j < 2; ++j) acc[i][j] = (f32x4){0.f, 0.f, 0.f, 0.f};
        u32x4 r0[6], r1[6], r2[6];
#define CG_LD(R, S) do { _Pragma("unroll") for (int q = 0; q < 2; ++q) R[q] = *(const u32x4*)(ag[q] + (S) * 128); _Pragma("unroll") for (int q = 0; q < 4; ++q) R[2 + q] = *(const u32x4*)(bg[q] + (S) * 128); } while (0)
#define CG_ST(R, BUF) do { LAS unsigned char* _b = lds + (BUF) * 52224; _Pragma("unroll") for (int q = 0; q < 2; ++q) *(LAS u32x4*)(_b + lofA[q]) = R[q]; _Pragma("unroll") for (int q = 0; q < 4; ++q) *(LAS u32x4*)(_b + lofB[q]) = R[2 + q]; } while (0)
#define CG_MM(BUF) do { const LAS unsigned char* _b = lds + (BUF) * 52224; _Pragma("unroll") for (int u = 0; u < 4; ++u) { bf16x8 Af[2], Bf[2]; \
            _Pragma("unroll") for (int i = 0; i < 2; ++i) { Af[i] = *(const LAS bf16x8*)(_b + (wr * 32 + i * 16 + fr) * 272 + (u * 32 + fq * 8) * 2); Bf[i] = *(const LAS bf16x8*)(_b + 17408 + (wc * 32 + i * 16 + fr) * 272 + (u * 32 + fq * 8) * 2); } \
            _Pragma("unroll") for (int i = 0; i < 2; ++i) _Pragma("unroll") for (int j = 0; j < 2; ++j) acc[i][j] = MFMA16(Bf[j], Af[i], acc[i][j]); } } while (0)
        CG_LD(r0, 0); CG_LD(r1, 1); CG_LD(r2, 2);
        CG_ST(r0, 0);
        __syncthreads();
        for (int s0 = 0; s0 < ns; s0 += 3) {
            { if (s0 + 1 < ns) CG_ST(r1, (s0 + 1) & 1); if (s0 + 3 < ns) CG_LD(r0, s0 + 3); CG_MM(s0 & 1); __syncthreads(); }
            if (s0 + 1 < ns) { if (s0 + 2 < ns) CG_ST(r2, (s0 + 2) & 1); if (s0 + 4 < ns) CG_LD(r1, s0 + 4); CG_MM((s0 + 1) & 1); __syncthreads(); }
            if (s0 + 2 < ns) { if (s0 + 3 < ns) CG_ST(r0, (s0 + 3) & 1); if (s0 + 5 < ns) CG_LD(r2, s0 + 5); CG_MM((s0 + 2) & 1); __syncthreads(); }
        }
#undef CG_LD
#undef CG_ST
#undef CG_MM
#pragma unroll
        for (int i = 0; i < 2; ++i) { const int r = rt * 64 + wr * 32 + i * 16 + fr; float ss = 0.f;
            f32x4 xin[2];
#pragma unroll
            for (int j = 0; j < 2; ++j) xin[j] = *(const f32x4*)(xc + (size_t)r * 1024 + ct * 128 + wc * 32 + j * 16 + fq * 4);
#pragma unroll
            for (int j = 0; j < 2; ++j) { const int c = ct * 128 + wc * 32 + j * 16 + fq * 4;
                const f32x4 gv = *(const f32x4*)(gate + c), gnv = *(const f32x4*)(gn + c);
                f32x4 x = xin[j] + gv * acc[i][j]; *(f32x4*)(xc + (size_t)r * 1024 + c) = x;
                ss += (x[0] * x[0] + x[1] * x[1]) + (x[2] * x[2] + x[3] * x[3]);
                const f32x4 y = x * gnv; u32x2 o; o.x = cvt_pk_bf16(y[0], y[1]); o.y = cvt_pk_bf16(y[2], y[3]); *(u32x2*)(xg + (size_t)r * 1024 + c) = o; }
            ss += __shfl_xor(ss, 16); ss += __shfl_xor(ss, 32);
            if (fq == 0) atomicAdd(ssw + r, (unsigned long long)(long long)llrintf(ss * 1048576.0f)); }
    }
}

__global__ void __launch_bounds__(512, 2) fwd_kernel(Params p) {
    extern __shared__ __attribute__((aligned(16))) unsigned char lds_raw[];
    LAS unsigned char* lds = (LAS unsigned char*)lds_raw;
    unsigned char* ws = p.ws;
    const int lo = p.ph_lo, hi = p.ph_hi;
    volatile LAS unsigned* bst = (volatile LAS unsigned*)(lds + BST_OFF);
    if (threadIdx.x < 2) bst[threadIdx.x] = 0u;
    __syncthreads();
    XcdBarrier bar; bar.bar = (unsigned*)(ws + OFF_BAR); bar.x = 0; bar.st = bst;
    if (hi - lo > 1) bar = xcd_barrier_post((unsigned*)(ws + OFF_BAR), bst);
#define IN(k) (lo <= (k) && (k) < hi)
#define SEAM(k) do { if (IN(k) && hi - lo > 1) { if ((k) == 0) cg::this_grid().sync(); else xcd_barrier(bar); if (DUP(20)) { xcd_barrier(bar); xcd_barrier(bar); } } } while (0)
#define MODP ((const float*)(ws + OFF_MOD))
#define GEMM_RUN(E, A_, B_, M_, N_, K_) do { StaticOrder S; S.init((M_), (N_), (int)gridDim.x, (int)blockIdx.x); gemm_phase(lds, (const bf16_t*)(A_), (const bf16_t*)(B_), (M_), (N_), (K_), S, E); } while (0)
    if (IN(0)) { prep_phase(p, lds); if (DUP(0)) { __syncthreads(); prep_phase(p, lds); } }
    SEAM(0);
    if (IN(1)) { modrms_phase(p, 0, 0, MALL, true); tables_phase(p, lds); if (DUP(1)) { __syncthreads(); modrms_phase(p, 0, 0, MALL, true); tables_phase(p, lds); } }
    SEAM(1);
    if (IN(2)) { Epi<1> E{}; E.U = (bf16_t*)(ws + OFF_U); E.V = (bf16_t*)(ws + OFF_V); E.bias = p.in[9]; E.stats = (unsigned long long*)(ws + OFF_STATS);
        GEMM_RUN(E, ws + OFF_H, ws + W_GMIN, MALL, 6144, 1024); }
    SEAM(2);
    if (IN(3)) spatial_phase(p, lds);
    SEAM(3);
    if (IN(4)) { Epi<2> E{}; E.xlat = p.out; E.xctx = (float*)(ws + OFF_XC); E.gate = MODP + 2 * 1024;
        E.xg = (bf16_t*)(ws + OFF_H); E.gn = (const float*)(ws + OFF_GN); E.ssw = (unsigned long long*)(ws + OFF_SS);
        ctx_gemm_phase(lds, (const bf16_t*)(ws + OFF_U) + (size_t)MLAT * 3072, (const bf16_t*)(ws + W_GMOUT), 3072, MODP + 2 * 1024 + 8 * 6144, (const float*)(ws + OFF_GN) + 8 * 1024,
                       (unsigned long long*)(ws + OFF_SS) + MLAT, (bf16_t*)(ws + OFF_H) + (size_t)MLAT * 1024, (float*)(ws + OFF_XC));
        GEMM_RUN(E, ws + OFF_U, ws + W_GMOUT, MLAT, 1024, 3072); }
    SEAM(4);
    if (IN(6)) { Epi<3> E{}; E.hid = (bf16_t*)(ws + OFF_U); E.ssr = (const long long*)(ws + OFF_SS); E.shb = (const float*)(ws + OFF_SHB); E.shn = 5632;
        GEMM_RUN(E, ws + OFF_H, ws + W_FFIN, MALL, 5632, 1024); if (DUP(6)) GEMM_RUN(E, ws + OFF_H, ws + W_FFIN, MALL, 5632, 1024); }
    SEAM(6);
    if (IN(7)) { Epi<2> E{}; E.xlat = p.out; E.xctx = (float*)(ws + OFF_XC); E.gate = MODP + 5 * 1024;
        E.xg = (bf16_t*)(ws + OFF_H); E.gn = (const float*)(ws + OFF_GN) + 9216; E.ssw = (unsigned long long*)(ws + OFF_SS) + MALL;
        ctx_gemm_phase(lds, (const bf16_t*)(ws + OFF_U) + (size_t)MLAT * 2816, (const bf16_t*)(ws + W_FFOUT), 2816, MODP + 5 * 1024 + 8 * 6144, (const float*)(ws + OFF_GN) + 9216 + 8 * 1024,
                       (unsigned long long*)(ws + OFF_SS) + MALL + MLAT, (bf16_t*)(ws + OFF_H) + (size_t)MLAT * 1024, (float*)(ws + OFF_XC));
        GEMM_RUN(E, ws + OFF_U, ws + W_FFOUT, MLAT, 1024, 2816); }
    SEAM(7);
    if (IN(9)) { Epi<4> E{}; E.proj = (bf16_t*)(ws + OFF_U); E.lbtab = (const float*)(ws + OFF_LB); E.ssr = (const long long*)(ws + OFF_SS) + MALL; E.shb = (const float*)(ws + OFF_SHB) + 9 * 5632; E.shn = 5632;
        GEMM_RUN(E, ws + OFF_H, ws + W_HGIN, MALL, 5120, 1024); }
    SEAM(9);
    if (IN(10)) { scan_phase(p, lds); if (DUP(10)) scan_phase(p, lds); }
    SEAM(10);
    if (IN(11)) { readout_phase(p); if (DUP(11)) readout_phase(p); }
    SEAM(11);
    if (IN(12)) { Epi<2> E{}; E.xlat = p.out; E.xctx = (float*)(ws + OFF_XC); E.gate = MODP + 9 * 6144 + 2 * 1024;
        E.xg = (bf16_t*)(ws + OFF_H); E.gn = (const float*)(ws + OFF_GN) + 2 * 9216; E.ssw = (unsigned long long*)(ws + OFF_SS) + 2 * MALL;
        GEMM_RUN(E, ws + OFF_U, ws + W_HGOUT, MLAT, 1024, 1024); }
    SEAM(12);
    if (IN(14)) { Epi<3> E{}; E.hid = (bf16_t*)(ws + OFF_U); E.ssr = (const long long*)(ws + OFF_SS) + 2 * MALL; E.shb = (const float*)(ws + OFF_SHB) + 2 * 9 * 5632; E.shn = 5632;
        GEMM_RUN(E, ws + OFF_H, ws + W_FFIN + (size_t)5632 * 1024 * 2, MLAT, 5632, 1024); }
    SEAM(14);
    if (IN(15)) { Epi<5> E{}; E.xlat = p.out; E.xctx = (float*)(ws + OFF_XC); E.gate = MODP + 9 * 6144 + 5 * 1024;
        GEMM_RUN(E, ws + OFF_U, ws + W_FFOUT + (size_t)1024 * 2816 * 2, MLAT, 1024, 2816); }
    SEAM(15);
    if (IN(16)) final_phase(p);
#undef IN
#undef SEAM
}

extern "C" void kernel_launch(void* const* d_in, const int* in_sizes, int n_in, void* d_out, int out_size, void* d_ws, size_t ws_size, hipStream_t stream) {
    static int grid = 0;
    if (grid == 0) {
        if (n_in != 22 || ws_size < WS_END) { fprintf(stderr, "kernel_launch: unexpected n_in %d / ws_size %zu (need %zu)\n", n_in, ws_size, (size_t)WS_END); grid = -1; return; }
        int dev = 0, cus = 0, per_cu = 0;
        (void)hipGetDevice(&dev); (void)hipDeviceGetAttribute(&cus, hipDeviceAttributeMultiprocessorCount, dev);
        if (hipFuncSetAttribute((const void*)fwd_kernel, hipFuncAttributeMaxDynamicSharedMemorySize, LDS_BYTES) != hipSuccess) { fprintf(stderr, "kernel_launch: hipFuncSetAttribute failed\n"); grid = -1; return; }
        (void)hipOccupancyMaxActiveBlocksPerMultiprocessor(&per_cu, (const void*)fwd_kernel, 512, LDS_BYTES);
        (void)hipGetLastError();
        if (per_cu < 1) per_cu = 1;
        grid = cus * 1;
        if (grid <= 0) grid = 256;
    }
    if (grid < 0) return;
    Params p{};
    for (int i = 0; i < 22; ++i) p.in[i] = (const float*)d_in[i];
    p.out = (float*)d_out; p.ws = (unsigned char*)d_ws;
#if COOP
    if (hipMemsetAsync((char*)d_ws + OFF_BAR, 0, 16384, stream) != hipSuccess) { fprintf(stderr, "kernel_launch: memset of the barrier words failed\n"); return; }
    p.ph_lo = 0; p.ph_hi = NPHASE;
    void* args[] = {&p};
    hipError_t e = hipLaunchCooperativeKernel((const void*)fwd_kernel, dim3(grid), dim3(512), args, LDS_BYTES, stream);
    if (e != hipSuccess) fprintf(stderr, "cooperative launch failed: %s (grid %d)\n", hipGetErrorString(e), grid);
#else
    for (int ph = 0; ph < NPHASE; ++ph) { p.ph_lo = ph; p.ph_hi = ph + 1; hipLaunchKernelGGL(fwd_kernel, dim3(grid), dim3(512), LDS_BYTES, stream, p); }
#endif
}
```

```cpp
#include <hip/hip_runtime.h>
#include <hip/hip_cooperative_groups.h>
#include <cstdio>
namespace cg = cooperative_groups;

#ifndef COOP
#define COOP 1
#endif

#ifndef PROBE_MASK
#define PROBE_MASK 0
#endif
#define DUP(k) ((PROBE_MASK >> (k)) & 1)
#define LAS __attribute__((address_space(3)))
typedef unsigned short bf16_t;
typedef short bf16x8 __attribute__((ext_vector_type(8)));
typedef float f32x4 __attribute__((ext_vector_type(4)));
typedef float f32x2 __attribute__((ext_vector_type(2)));
typedef unsigned u32x4 __attribute__((ext_vector_type(4)));
typedef unsigned u32x2 __attribute__((ext_vector_type(2)));

constexpr int MLAT = 65536, MCTX = 2048, MALL = 67584;
constexpr float EPS = 1e-6f;
constexpr int NPHASE = 17;
constexpr int XOFF = 131072 + 64;
constexpr int LDS_BYTES = 163840;
constexpr int BST_OFF = 163840 - 64;

constexpr size_t SECE = (size_t)MALL * 1024;
constexpr size_t SEC = SECE * 2;
constexpr size_t OFF_XC = 0;
constexpr size_t OFF_H = 8388608;
constexpr size_t OFF_U = OFF_H + SEC;
constexpr size_t OFF_V = OFF_U + 3 * SEC;
constexpr size_t OFF_W = OFF_V + 3 * SEC;
constexpr size_t W_GMIN = OFF_W;
constexpr size_t W_GMOUT = W_GMIN + (size_t)6144 * 1024 * 2;
constexpr size_t W_HGIN = W_GMOUT + (size_t)1024 * 3072 * 2;
constexpr size_t W_HGOUT = W_HGIN + (size_t)5120 * 1024 * 2;
constexpr size_t W_FFIN = W_HGOUT + (size_t)1024 * 1024 * 2;
constexpr size_t W_FFOUT = W_FFIN + (size_t)2 * 5632 * 1024 * 2;
constexpr size_t W_WS = W_FFOUT + (size_t)2 * 1024 * 2816 * 2;
constexpr size_t OFF_MOD = W_WS + (size_t)8 * 128 * 128 * 2;
constexpr size_t OFF_STATS = OFF_MOD + (size_t)2 * 9 * 6144 * 4;
constexpr size_t OFF_POS = OFF_STATS + (size_t)MALL * 2 * 8;
constexpr size_t OFF_LB = OFF_POS + (size_t)192 * 512 * 4;
constexpr size_t OFF_SS = OFF_LB + 2048 * 4;
constexpr size_t OFF_SHB = OFF_SS + (size_t)3 * MALL * 8;
constexpr size_t OFF_GN = OFF_SHB + (size_t)3 * 9 * 5632 * 4;
constexpr size_t OFF_BAR = OFF_GN + (size_t)3 * 9 * 1024 * 4;
constexpr size_t BAR_BYTES = 3456 * 4;
constexpr size_t WS_END = OFF_BAR + 16384;

struct Params { const float* in[22]; float* out; unsigned char* ws; int ph_lo, ph_hi; };

typedef __bf16 bf16x2_t __attribute__((ext_vector_type(2)));
__device__ __forceinline__ unsigned cvt_pk_bf16(float lo, float hi) { const f32x2 v = {lo, hi}; const bf16x2_t r = __builtin_convertvector(v, bf16x2_t); return __builtin_bit_cast(unsigned, r); }
__device__ __forceinline__ float bf2f(unsigned short b) { return __uint_as_float(((unsigned)b) << 16); }
__device__ __forceinline__ float bflo(unsigned w) { return __uint_as_float(w << 16); }
__device__ __forceinline__ float bfhi(unsigned w) { return __uint_as_float(w & 0xffff0000u); }
__device__ __forceinline__ float wave_sum(float v) {
#pragma unroll
    for (int o = 1; o < 64; o <<= 1) v += __shfl_xor(v, o);
    return v;
}
__device__ __forceinline__ float silu_f(float a) { return a * __builtin_amdgcn_rcpf(1.0f + __expf(-a)); }
#define LDS_WAIT() asm volatile("s_waitcnt lgkmcnt(0)" ::: "memory")
#define MFMA16(a, b, c) __builtin_amdgcn_mfma_f32_16x16x32_bf16((a), (b), (c), 0, 0, 0)

__device__ __forceinline__ f32x2 gelu_pk(f32x2 v) {
    const f32x2 av = __builtin_elementwise_abs(v), d = av * 0.2316418882f + 1.0f;
    f32x2 t; t.x = __builtin_amdgcn_rcpf(d.x); t.y = __builtin_amdgcn_rcpf(d.y);
    f32x2 q = t * 0.5307027145f + (-0.7265760135f); q = q * t + 0.7107068705f; q = q * t + (-0.142248368f); q = q * t + 0.127414796f; q = q * t;
    const f32x2 s = (v * v) * (-0.72134752044f);
    f32x2 e; e.x = __builtin_amdgcn_exp2f(s.x); e.y = __builtin_amdgcn_exp2f(s.y);
    const f32x2 z = {0.f, 0.f};
    return __builtin_elementwise_max(v, z) - av * (q * e);
}

constexpr int BM = 256, BK = 64, HALF = 128, HTB = HALF * BK * 2, NXCD = 8, WGM = 8;
__device__ __forceinline__ int lds_byte(int r, int c) { const int st = (r >> 4) * 2 + (c >> 5), rr = r & 15, cc = c & 31, ob = rr * 64 + cc * 2; return st * 1024 + (ob ^ (((ob >> 9) & 1) << 5)); }
__device__ __forceinline__ void stage_rc(int b, int& R, int& C) { const int st = b / 1024, sb = b % 1024, swz = sb ^ (((sb >> 9) & 1) << 5); R = (st >> 1) * 16 + swz / 64; C = (st & 1) * 32 + (swz % 64) / 2; }
__device__ __forceinline__ int perm32(int rho) { const int n = rho >> 4, i = rho & 15; return 8 * (i >> 2) + 4 * n + (i & 3); }

struct Unit { int pm, pn; };
struct StaticOrder {
    int nM, nN, nwg, G, c;
    __device__ void init(int M, int N, int G_, int c_) { nM = M / BM; nN = N / BM; nwg = nM * nN; G = G_; c = c_; }
    __device__ bool next(int i, Unit& u) const {
        const long L = (long)i * G + c; if (L >= nwg) return false;
        int wgid = (int)L; { const int q = nwg / NXCD, r = nwg % NXCD, xcd = wgid % NXCD, off = wgid / NXCD; wgid = (xcd < r ? xcd * (q + 1) : r * (q + 1) + (xcd - r) * q) + off; }
        const int nig = WGM * nN, gid = wgid / nig, fm = gid * WGM, gsz = (nM - fm) < WGM ? (nM - fm) : WGM;
        u.pm = fm + ((wgid % nig) % gsz); u.pn = (wgid % nig) / gsz; return true;
    }
};

template <int kind> struct Epi {
    static constexpr bool perm = true;
    static constexpr bool PRE = (kind == 3 || kind == 4 || kind == 2 || kind == 5);
    __device__ __forceinline__ void pre(LAS unsigned char* lx, const Unit& u, int wid, int lane) const {
        if constexpr (kind == 2 || kind == 5) {
            const int bi = (u.pm * BM) >> 13;
            if (wid < 4) __builtin_amdgcn_global_load_lds((const unsigned*)(gate + bi * 6144 + u.pn * BM + wid * 64 + lane), (LAS unsigned*)(lx + wid * 256), 4, 0, 0);
            else if (kind == 2) __builtin_amdgcn_global_load_lds((const unsigned*)(gn + bi * 1024 + u.pn * BM + (wid - 4) * 64 + lane), (LAS unsigned*)(lx + 1024 + (wid - 4) * 256), 4, 0, 0);
        } else if constexpr (PRE) {
            const unsigned* src = (const unsigned*)(ssr + (size_t)u.pm * BM) + wid * 64 + lane;
            __builtin_amdgcn_global_load_lds(src, (LAS unsigned*)(lx + wid * 256), 4, 0, 0);
            if (wid < 4) { const int bi = u.pm * BM < MLAT ? ((u.pm * BM) >> 13) : 8; const float* s2 = shb + bi * shn + u.pn * BM + wid * 64 + lane;
                __builtin_amdgcn_global_load_lds((const unsigned*)s2, (LAS unsigned*)(lx + 2048 + wid * 256), 4, 0, 0); }
        }
    }
    bf16_t* U; bf16_t* V; const float* bias; unsigned long long* stats;
    float* xlat; float* xctx; const float* gate;
    bf16_t* xg; const float* gn; unsigned long long* ssw;
    const long long* ssr; const float* shb; int shn;
    bf16_t* hid;
    bf16_t* proj; const float* lbtab;
    __device__ __forceinline__ void operator()(const f32x4 (&acc)[2][2][4][2], const Unit& u, int wr, int wc, int fr, int fq, LAS unsigned char* lx) const {
        if constexpr (kind == 1) {
            const int row0 = u.pm * BM + wr * 64 + fr; int colt = u.pn * BM; const bool vh = colt >= 3072; bf16_t* base = vh ? V : U; if (vh) colt -= 3072;
            const int col0 = colt + wc * 32 + 8 * fq, bcol0 = u.pn * BM + wc * 32 + 8 * fq;
            f32x4 bv[2][2];
#pragma unroll
            for (int bj = 0; bj < 2; ++bj)
#pragma unroll
                for (int n = 0; n < 2; ++n) bv[bj][n] = *(const f32x4*)(bias + bcol0 + bj * HALF + 4 * n);
#pragma unroll
            for (int ai = 0; ai < 2; ++ai)
#pragma unroll
                for (int m = 0; m < 4; ++m) {
                    const int row = row0 + ai * HALF + m * 16; bf16_t* rowp = base + (size_t)row * 3072 + col0; float s = 0.f, ss = 0.f;
#pragma unroll
                    for (int bj = 0; bj < 2; ++bj) {
                        f32x4 v0 = acc[ai][bj][m][0] + bv[bj][0], v1 = acc[ai][bj][m][1] + bv[bj][1];
                        f32x2 a = (f32x2){v0[0], v0[1]}, b = (f32x2){v0[2], v0[3]}, c = (f32x2){v1[0], v1[1]}, d = (f32x2){v1[2], v1[3]};
                        if (vh) { a = gelu_pk(a); b = gelu_pk(b); c = gelu_pk(c); d = gelu_pk(d);
                            s += (a.x + a.y) + (b.x + b.y) + (c.x + c.y) + (d.x + d.y);
                            ss += (a.x * a.x + a.y * a.y) + (b.x * b.x + b.y * b.y) + (c.x * c.x + c.y * c.y) + (d.x * d.x + d.y * d.y); }
                        u32x4 w; w.x = cvt_pk_bf16(a.x, a.y); w.y = cvt_pk_bf16(b.x, b.y); w.z = cvt_pk_bf16(c.x, c.y); w.w = cvt_pk_bf16(d.x, d.y);
                        *(u32x4*)(rowp + bj * HALF) = w;
                    }
                    if (vh) {
                        s += __shfl_xor(s, 16); s += __shfl_xor(s, 32); ss += __shfl_xor(ss, 16); ss += __shfl_xor(ss, 32);
                        if (fq == 0) { atomicAdd(stats + 2 * row, (unsigned long long)(long long)llrintf(s * 1048576.0f)); atomicAdd(stats + 2 * row + 1, (unsigned long long)(long long)llrintf(ss * 1048576.0f)); }
                    }
                }
        } else if constexpr (kind == 2 || kind == 5) {
            const int rowbase = u.pm * BM;
            bf16_t* Xb = (bf16_t*)xlat + (size_t)rowbase * 2048;
            const int col0 = u.pn * BM + wc * 32 + 8 * fq;
            float ss[2][4];
#pragma unroll
            for (int ai = 0; ai < 2; ++ai)
#pragma unroll
                for (int m = 0; m < 4; ++m) ss[ai][m] = 0.f;
#define R_LOAD(X, BJ, AI) do { _Pragma("unroll") for (int m = 0; m < 4; ++m) X[m] = *(const u32x4*)(Xb + (size_t)(wr * 64 + fr + (AI) * HALF + m * 16) * 2048 + col0 + (BJ) * HALF); } while (0)
#define R_PROC(X, BJ, AI) do { const LAS float* lg = (const LAS float*)lx + (BJ) * HALF + wc * 32 + 8 * fq; \
                _Pragma("unroll") for (int m = 0; m < 4; ++m) { const int rl = wr * 64 + fr + (AI) * HALF + m * 16; const int co = col0 + (BJ) * HALF; const u32x4 xi = X[m]; \
                    const f32x4 gv0 = *(const volatile LAS f32x4*)lg, gv1 = *(const volatile LAS f32x4*)(lg + 4);   \
                    f32x4 gn0 = gv0, gn1 = gv1; if constexpr (kind == 2) { gn0 = *(const volatile LAS f32x4*)(lg + 256); gn1 = *(const volatile LAS f32x4*)(lg + 260); } \
                    const f32x4 x0 = (f32x4){bflo(xi.x), bfhi(xi.x), bflo(xi.y), bfhi(xi.y)} + gv0 * acc[AI][BJ][m][0], x1 = (f32x4){bflo(xi.z), bfhi(xi.z), bflo(xi.w), bfhi(xi.w)} + gv1 * acc[AI][BJ][m][1]; \
                    u32x4 xo; xo.x = cvt_pk_bf16(x0[0], x0[1]); xo.y = cvt_pk_bf16(x0[2], x0[3]); xo.z = cvt_pk_bf16(x1[0], x1[1]); xo.w = cvt_pk_bf16(x1[2], x1[3]); \
                    *(u32x4*)(Xb + (size_t)rl * 2048 + co) = xo; \
                    if constexpr (kind == 2) { \
                        ss[AI][m] += ((x0[0] * x0[0] + x0[1] * x0[1]) + (x0[2] * x0[2] + x0[3] * x0[3])) + ((x1[0] * x1[0] + x1[1] * x1[1]) + (x1[2] * x1[2] + x1[3] * x1[3])); \
                        const f32x4 y0 = x0 * gn0, y1 = x1 * gn1; \
                        u32x4 o; o.x = cvt_pk_bf16(y0[0], y0[1]); o.y = cvt_pk_bf16(y0[2], y0[3]); o.z = cvt_pk_bf16(y1[0], y1[1]); o.w = cvt_pk_bf16(y1[2], y1[3]); \
                        *(u32x4*)(xg + (size_t)(rowbase + rl) * 1024 + co) = o; } } } while (0)
            u32x4 xa[4], xb[4], xc_[4], xd[4];
            R_LOAD(xa, 0, 0); R_LOAD(xb, 0, 1);
            R_PROC(xa, 0, 0);
            R_LOAD(xc_, 1, 0);
            R_PROC(xb, 0, 1);
            R_LOAD(xd, 1, 1);
            R_PROC(xc_, 1, 0);
            R_PROC(xd, 1, 1);
#undef R_LOAD
#undef R_PROC
            if constexpr (kind == 2) {
#pragma unroll
                for (int ai = 0; ai < 2; ++ai)
#pragma unroll
                    for (int m = 0; m < 4; ++m) { float t = ss[ai][m]; t += __shfl_xor(t, 16); t += __shfl_xor(t, 32);
                        if (fq == 0) atomicAdd(ssw + rowbase + wr * 64 + fr + ai * HALF + m * 16, (unsigned long long)(long long)llrintf(t * 1048576.0f)); }
            }
        } else if constexpr (kind == 3) {
            const int rowbase = u.pm * BM; const int bi = rowbase < MLAT ? (rowbase >> 13) : 8;
            const int row0 = rowbase + wr * 64 + fr, col0 = u.pn * HALF + wc * 32 + 8 * fq;
            const LAS float* sp = (const LAS float*)(lx + 2048) + wc * 32 + 8 * fq;
            const f32x4 sa0 = *(const LAS f32x4*)sp, sa1 = *(const LAS f32x4*)(sp + 4), sb0 = *(const LAS f32x4*)(sp + HALF), sb1 = *(const LAS f32x4*)(sp + HALF + 4);
#pragma unroll
            for (int ai = 0; ai < 2; ++ai)
#pragma unroll
                for (int m = 0; m < 4; ++m) { const int row = row0 + ai * HALF + m * 16; bf16_t* rowp = hid + (size_t)row * 2816 + col0;
                    const float rs = __builtin_amdgcn_rsqf((float)(*(const LAS long long*)(lx + (wr * 64 + fr + ai * HALF + m * 16) * 8)) * (1.0f / (1048576.0f * 1024.0f)) + EPS);
                    const f32x4 a0 = acc[ai][0][m][0] * rs + sa0, a1 = acc[ai][0][m][1] * rs + sa1, b0 = acc[ai][1][m][0] * rs + sb0, b1 = acc[ai][1][m][1] * rs + sb1;
                    u32x4 w; w.x = cvt_pk_bf16(silu_f(a0[0]) * b0[0], silu_f(a0[1]) * b0[1]); w.y = cvt_pk_bf16(silu_f(a0[2]) * b0[2], silu_f(a0[3]) * b0[3]);
                    w.z = cvt_pk_bf16(silu_f(a1[0]) * b1[0], silu_f(a1[1]) * b1[1]); w.w = cvt_pk_bf16(silu_f(a1[2]) * b1[2], silu_f(a1[3]) * b1[3]);
                    *(u32x4*)rowp = w; }
        } else {
            const int sec = u.pn >> 2; const int row0 = u.pm * BM + wr * 64 + fr, col0 = (u.pn & 3) * BM + wc * 32 + 8 * fq;
            bf16_t* base = proj + (size_t)sec * SECE;
            float rs[2][4];
#pragma unroll
            for (int ai = 0; ai < 2; ++ai)
#pragma unroll
                for (int m = 0; m < 4; ++m) rs[ai][m] = __builtin_amdgcn_rsqf((float)(*(const LAS long long*)(lx + (wr * 64 + fr + ai * HALF + m * 16) * 8)) * (1.0f / (1048576.0f * 1024.0f)) + EPS);
#pragma unroll
            for (int bj = 0; bj < 2; ++bj) {
                const LAS float* sp = (const LAS float*)(lx + 2048) + wc * 32 + 8 * fq + bj * HALF;
                const f32x4 sh0 = *(const LAS f32x4*)sp, sh1 = *(const LAS f32x4*)(sp + 4);
                f32x4 lb0 = (f32x4){0.f, 0.f, 0.f, 0.f}, lb1 = lb0;
                if (sec == 1 || sec == 2) { const float* lp = lbtab + (sec - 1) * 1024 + col0 + bj * HALF; lb0 = *(const f32x4*)lp; lb1 = *(const f32x4*)(lp + 4); }
#pragma unroll
                for (int ai = 0; ai < 2; ++ai)
#pragma unroll
                    for (int m = 0; m < 4; ++m) { bf16_t* rowp = base + (size_t)(row0 + ai * HALF + m * 16) * 1024 + col0;
                        f32x4 v0 = acc[ai][bj][m][0] * rs[ai][m] + sh0, v1 = acc[ai][bj][m][1] * rs[ai][m] + sh1;
                        if (sec == 0 || sec == 4) {
#pragma unroll
                            for (int j = 0; j < 4; ++j) { v0[j] = silu_f(v0[j]); v1[j] = silu_f(v1[j]); }
                        } else if (sec == 1 || sec == 2) {
#pragma unroll
                            for (int j = 0; j < 4; ++j) {
                                v0[j] = lb0[j] * __builtin_amdgcn_rcpf(1.0f + __expf(v0[j]));
                                v1[j] = lb1[j] * __builtin_amdgcn_rcpf(1.0f + __expf(v1[j])); }
                        }
                        u32x4 w; w.x = cvt_pk_bf16(v0[0], v0[1]); w.y = cvt_pk_bf16(v0[2], v0[3]); w.z = cvt_pk_bf16(v1[0], v1[1]); w.w = cvt_pk_bf16(v1[2], v1[3]);
                        *(u32x4*)(rowp + bj * HALF) = w; }
            }
        }
    }
};

template <class EpiT> __device__ __forceinline__ void gemm_phase(LAS unsigned char* lds, const bf16_t* gA, const bf16_t* gBt, int M, int N, int K, const StaticOrder& S, const EpiT& E) {
    const int tid = threadIdx.x, wid = __builtin_amdgcn_readfirstlane(tid >> 6), lane = tid & 63, wr = wid >> 2, wc = wid & 3, fr = lane & 15, fq = lane >> 4;
    const int nt = K / BK;
    unsigned voffA[2], voffB[2];
#pragma unroll
    for (int i = 0; i < 2; ++i) { int R, C; stage_rc(tid * 16 + i * 8192, R, C); const int Rb = EpiT::perm ? ((R & ~31) + perm32(R & 31)) : R;
        voffA[i] = (unsigned)(R * K + C) * 2u; voffB[i] = (unsigned)(Rb * K + C) * 2u; }
    const size_t kstep = (size_t)(BK * 2);
    const size_t hstep = (size_t)HALF * K * 2;
    const size_t tstep = 2 * hstep;
    const unsigned ldsw = (unsigned)wid * 1024u;
    const int aoff = lds_byte(wr * 64 + fr, fq * 8), boff = lds_byte(wc * 32 + fr, fq * 8);
#define PG8_SA(b, h) (((b) * 2 + (h)) * HTB)
#define PG8_SB(b, h) ((4 + (b) * 2 + (h)) * HTB)
#define PG8_STAGE(bufoff, gbase, voff) do { _Pragma("unroll") for (int _i = 0; _i < 2; ++_i) \
        __builtin_amdgcn_global_load_lds((const unsigned*)((const char*)(gbase) + (voff)[_i]), (LAS unsigned*)(lds + (bufoff) + ldsw + _i * 8192), 16, 0, 0); } while (0)
#define PG8_LDA(dst, b, h) do { _Pragma("unroll") for (int m = 0; m < 4; ++m) _Pragma("unroll") for (int k = 0; k < 2; ++k) dst[m][k] = *(const LAS bf16x8*)(lds + PG8_SA(b, h) + aoff + m * 2048 + k * 1024); } while (0)
#define PG8_LDB(dst, b, h) do { _Pragma("unroll") for (int n = 0; n < 2; ++n) _Pragma("unroll") for (int k = 0; k < 2; ++k) dst[n][k] = *(const LAS bf16x8*)(lds + PG8_SB(b, h) + boff + n * 2048 + k * 1024); } while (0)
#define PG8_MMA(ai, bj, At, Bt) do { __builtin_amdgcn_s_setprio(1); _Pragma("unroll") for (int m = 0; m < 4; ++m) _Pragma("unroll") for (int n = 0; n < 2; ++n) _Pragma("unroll") for (int k = 0; k < 2; ++k) \
        acc[ai][bj][m][n] = __builtin_amdgcn_mfma_f32_16x16x32_bf16(Bt[n][k], At[m][k], acc[ai][bj][m][n], 0, 0, 0); __builtin_amdgcn_s_setprio(0); } while (0)
#define PG8_WAIT_V(n) asm volatile("s_waitcnt vmcnt(" #n ")" ::: "memory")
#define PG8_WAIT_L(n) asm volatile("s_waitcnt lgkmcnt(" #n ")" ::: "memory")
#define PG8_BAR __builtin_amdgcn_s_barrier()
#define PG8_SCHED __builtin_amdgcn_sched_barrier(0)
    Unit cur, nxt; int ui = 0;
    if (!S.next(0, cur)) return;
    f32x4 acc[2][2][4][2];
#pragma unroll
    for (int a = 0; a < 2; ++a)
#pragma unroll
        for (int b = 0; b < 2; ++b)
#pragma unroll
            for (int m = 0; m < 4; ++m)
#pragma unroll
                for (int n = 0; n < 2; ++n) acc[a][b][m][n] = (f32x4){0.f, 0.f, 0.f, 0.f};
    bf16x8 At[4][2], B0[2][2], B1[2][2];
    const char* cA = (const char*)gA + (size_t)cur.pm * tstep; const char* cB = (const char*)gBt + (size_t)cur.pn * tstep;
    E.pre(lds + XOFF, cur, wid, lane);
    PG8_STAGE(PG8_SB(0, 0), cB, voffB); PG8_STAGE(PG8_SA(0, 0), cA, voffA); PG8_STAGE(PG8_SB(0, 1), cB + hstep, voffB); PG8_STAGE(PG8_SA(0, 1), cA + hstep, voffA);
    if (wr == 1) PG8_BAR;
    PG8_WAIT_V(4); PG8_BAR;
    PG8_STAGE(PG8_SB(1, 0), cB + kstep, voffB); PG8_STAGE(PG8_SA(1, 0), cA + kstep, voffA); PG8_STAGE(PG8_SB(1, 1), cB + hstep + kstep, voffB);
    PG8_WAIT_V(6); PG8_BAR;
    for (;;) {
        const bool has_next = S.next(ui + 1, nxt);
        const char* nA = has_next ? (const char*)gA + (size_t)nxt.pm * tstep : cA; const char* nB = has_next ? (const char*)gBt + (size_t)nxt.pn * tstep : cB;
        for (int t = 0; t < nt; t += 2) {
            const bool last = (t == nt - 2);
            const char* a1 = cA + (size_t)(t + 1) * kstep;
            const char* a2 = last ? nA : cA + (size_t)(t + 2) * kstep; const char* b2 = last ? nB : cB + (size_t)(t + 2) * kstep;
            const char* a3 = a2 + kstep; const char* b3 = b2 + kstep;
            PG8_LDB(B0, 0, 0); PG8_SCHED; PG8_LDA(At, 0, 0); PG8_STAGE(PG8_SA(1, 1), a1 + hstep, voffA);
            PG8_WAIT_L(8); PG8_BAR; PG8_WAIT_L(0); PG8_MMA(0, 0, At, B0); PG8_BAR; PG8_SCHED;
            PG8_LDB(B1, 0, 1); PG8_STAGE(PG8_SB(0, 0), b2, voffB);
            PG8_BAR; PG8_WAIT_L(0); PG8_MMA(0, 1, At, B1); PG8_BAR;
            PG8_LDA(At, 0, 1); PG8_STAGE(PG8_SA(0, 0), a2, voffA);
            PG8_BAR; PG8_WAIT_L(0); PG8_MMA(1, 0, At, B0); PG8_BAR; PG8_SCHED;
            PG8_STAGE(PG8_SB(0, 1), b2 + hstep, voffB);
            PG8_WAIT_V(6); PG8_BAR; PG8_MMA(1, 1, At, B1); PG8_BAR;
            PG8_LDB(B0, 1, 0); PG8_SCHED; PG8_LDA(At, 1, 0); PG8_STAGE(PG8_SA(0, 1), a2 + hstep, voffA);
            PG8_WAIT_L(8); PG8_BAR; PG8_WAIT_L(0); PG8_MMA(0, 0, At, B0); PG8_BAR; PG8_SCHED;
            PG8_LDB(B1, 1, 1); PG8_STAGE(PG8_SB(1, 0), b3, voffB);
            PG8_BAR; PG8_WAIT_L(0); PG8_MMA(0, 1, At, B1); PG8_BAR;
            PG8_LDA(At, 1, 1); PG8_STAGE(PG8_SA(1, 0), a3, voffA);
            PG8_BAR; PG8_WAIT_L(0); PG8_MMA(1, 0, At, B0); PG8_BAR; PG8_SCHED;
            PG8_STAGE(PG8_SB(1, 1), b3 + hstep, voffB);
            PG8_WAIT_V(6); PG8_BAR; PG8_MMA(1, 1, At, B1); PG8_BAR;
        }
        E(acc, cur, wr, wc, fr, fq, lds + XOFF + (ui & 1) * 3072);
        if (!has_next) break;
        E.pre(lds + XOFF + ((ui + 1) & 1) * 3072, nxt, wid, lane);
#pragma unroll
        for (int a = 0; a < 2; ++a)
#pragma unroll
            for (int b = 0; b < 2; ++b)
#pragma unroll
                for (int m = 0; m < 4; ++m)
#pragma unroll
                    for (int n = 0; n < 2; ++n) acc[a][b][m][n] = (f32x4){0.f, 0.f, 0.f, 0.f};
        cur = nxt; cA = nA; cB = nB; ++ui;
    }
    PG8_WAIT_V(0);
    if (wr == 0) PG8_BAR;
    PG8_BAR;
#undef PG8_SA
#undef PG8_SB
#undef PG8_STAGE
#undef PG8_LDA
#undef PG8_LDB
#undef PG8_MMA
#undef PG8_WAIT_V
#undef PG8_WAIT_L
#undef PG8_BAR
#undef PG8_SCHED
}

__device__ __forceinline__ void transpose_item(const float* W, int K, int N, bf16_t* WT, int dest_row0, int k0, int n0, LAS float* scr, int lane) {
#pragma unroll 8
    for (int i = 0; i < 32; ++i) { const int kk = 2 * i + (lane >> 5); scr[kk * 33 + (lane & 31)] = W[(size_t)(k0 + kk) * N + n0 + (lane & 31)]; }
    LDS_WAIT();
    const int c = lane & 7;
#pragma unroll
    for (int j = 0; j < 4; ++j) { const int n = (lane >> 3) + 8 * j; const LAS float* s = scr + (8 * c) * 33 + n;
        u32x4 o; o.x = cvt_pk_bf16(s[0 * 33], s[1 * 33]); o.y = cvt_pk_bf16(s[2 * 33], s[3 * 33]); o.z = cvt_pk_bf16(s[4 * 33], s[5 * 33]); o.w = cvt_pk_bf16(s[6 * 33], s[7 * 33]);
        *(u32x4*)(WT + (size_t)(dest_row0 + n) * K + k0 + 8 * c) = o; }
    LDS_WAIT();
}

__device__ __forceinline__ void prep_phase(const Params& p, LAS unsigned char* lds) {
    const int tid = threadIdx.x, lane = tid & 63, w = __builtin_amdgcn_readfirstlane(tid >> 6);
    unsigned char* ws = p.ws;
    {
        LAS float* sS = (LAS float*)(lds + 73728);
        LAS float* part = (LAS float*)(lds + 110592);
        float* mod = (float*)(ws + OFF_MOD);
        for (int it = blockIdx.x; it < 192; it += gridDim.x) {
            const int layer = it / 96, n0 = (it % 96) * 64;
            for (int idx = tid; idx < 9216; idx += 512) { const int j = idx >> 10, k = idx & 1023; const float v = j < 8 ? p.in[1][j * 1024 + k] : p.in[3][k]; sS[idx] = v / (1.0f + __expf(-v)); }
            __syncthreads();
            float a[9];
#pragma unroll
            for (int j = 0; j < 9; ++j) a[j] = 0.f;
            const float* wp = p.in[4] + ((size_t)layer * 1024 + w * 128) * 6144 + n0 + lane;
#pragma unroll 8
            for (int kk = 0; kk < 128; ++kk) { const float wv = wp[(size_t)kk * 6144];
#pragma unroll
                for (int j = 0; j < 9; ++j) a[j] += sS[j * 1024 + w * 128 + kk] * wv; }
#pragma unroll
            for (int j = 0; j < 9; ++j) part[(w * 9 + j) * 64 + lane] = a[j];
            __syncthreads();
            for (int idx = tid; idx < 576; idx += 512) { const int j = idx >> 6, l = idx & 63; float s = p.in[5][layer * 6144 + n0 + l];
#pragma unroll
                for (int ww = 0; ww < 8; ++ww) s += part[(ww * 9 + j) * 64 + l];
                mod[(layer * 9 + j) * 6144 + n0 + l] = s; }
            __syncthreads();
        }
    }
    {
        LAS float* scr = (LAS float*)(lds + w * 8448);
        const int gw = blockIdx.x * 8 + w, NGW = gridDim.x * 8;
        for (int it = gw; it < 16128; it += NGW) {
            int r = it; const float* W; bf16_t* WT; int K, N, swz = 0;
            if (r < 3072) { W = p.in[8]; WT = (bf16_t*)(ws + W_GMIN); K = 1024; N = 6144; }
            else if ((r -= 3072) < 1536) { W = p.in[14]; WT = (bf16_t*)(ws + W_GMOUT); K = 3072; N = 1024; }
            else if ((r -= 1536) < 2560) { W = p.in[15]; WT = (bf16_t*)(ws + W_HGIN); K = 1024; N = 5120; }
            else if ((r -= 2560) < 512) { W = p.in[18]; WT = (bf16_t*)(ws + W_HGOUT); K = 1024; N = 1024; }
            else if ((r -= 512) < 5632) { const int l = r / 2816; r -= l * 2816; W = p.in[19] + (size_t)l * 1024 * 5632; WT = (bf16_t*)(ws + W_FFIN) + (size_t)l * 5632 * 1024; K = 1024; N = 5632; swz = 1; }
            else { r -= 5632; const int l = r / 1408; r -= l * 1408; W = p.in[20] + (size_t)l * 2816 * 1024; WT = (bf16_t*)(ws + W_FFOUT) + (size_t)l * 1024 * 2816; K = 2816; N = 1024; }
            const int nblk = N / 32, kb = r / nblk, nb = r % nblk, k0 = 64 * kb, n0 = 32 * nb;
            int dest = n0;
            if (swz) { if (n0 < 2816) dest = (n0 >> 7) * 256 + (n0 & 127); else { const int j = n0 - 2816; dest = (j >> 7) * 256 + 128 + (j & 127); } }
            transpose_item(W, K, N, WT, dest, k0, n0, scr, lane);
        }
    }
    const int gt = blockIdx.x * 512 + tid, NT = gridDim.x * 512;
    { bf16_t* wsb = (bf16_t*)(ws + W_WS); for (int i = gt; i < 65536; i += NT) { const float a = p.in[12][2 * i], b = p.in[12][2 * i + 1]; ((unsigned*)wsb)[i] = cvt_pk_bf16(a, b); } }
    { unsigned long long* st = (unsigned long long*)(ws + OFF_STATS); for (int i = gt; i < MALL * 2; i += NT) st[i] = 0ull; }
    { unsigned long long* st = (unsigned long long*)(ws + OFF_SS); for (int i = gt; i < MALL * 3; i += NT) st[i] = 0ull; }
    { float* pos = (float*)(ws + OFF_POS); for (int i = gt; i < 192 * 512; i += NT) { const int pp = i >> 9, j = i & 511; const float ps = (float)(pp < 128 ? pp : pp - 128);
            const float om = expf(-(float)(j & 255) * (9.210340371976184f / 256.0f)); const float ang = ps * om; pos[i] = j < 256 ? sinf(ang) : cosf(ang); } }
    { float* lb = (float*)(ws + OFF_LB); for (int i = gt; i < 2048; i += NT) { const float l0 = p.in[16][i], l1 = p.in[16][2048 + i]; lb[i] = 1.0f - 1.0f / (1.0f + expf(l0 - l1)); } }
}

__device__ __forceinline__ void modrms_phase(const Params& p, int layer, int which, int nrows, bool first) {
    const int lane = threadIdx.x & 63, w = __builtin_amdgcn_readfirstlane(threadIdx.x >> 6);
    const int gw = blockIdx.x * 8 + w, NGW = gridDim.x * 8;
    const float* nw = p.in[which ? 7 : 6] + layer * 1024;
    const float* modl = (const float*)(p.ws + OFF_MOD) + layer * 9 * 6144 + (which ? 3 : 0) * 1024;
    const float* pos = (const float*)(p.ws + OFF_POS);
    bf16_t* H = (bf16_t*)(p.ws + OFF_H);
    float* xc = (float*)(p.ws + OFF_XC);
    for (int row0 = gw; row0 < nrows; row0 += 2 * NGW) {
        f32x4 v[2][4];
#pragma unroll
        for (int r = 0; r < 2; ++r) { const int row = row0 + r * NGW;
            if (row < nrows) {
                float* xp = row < MLAT ? p.out + (size_t)row * 1024 : xc + (size_t)(row - MLAT) * 1024;
                if (first) {
                    const float* src = row < MLAT ? p.in[0] + (size_t)row * 1024 : p.in[2] + (size_t)(row - MLAT) * 1024;
#pragma unroll
                    for (int j = 0; j < 4; ++j) v[r][j] = *(const f32x4*)(src + 256 * j + 4 * lane);
                    if (row < MLAT) { const int t = row & 8191, pr = t >> 6, pc = t & 63;
#pragma unroll
                        for (int j = 0; j < 4; ++j) { const float* pp = j < 2 ? pos + pr * 512 + 256 * j + 4 * lane : pos + (128 + pc) * 512 + 256 * (j - 2) + 4 * lane; v[r][j] = v[r][j] + *(const f32x4*)pp; } }
                } else {
#pragma unroll
                    for (int j = 0; j < 4; ++j) v[r][j] = *(const f32x4*)(xp + 256 * j + 4 * lane);
                }
            } else {
#pragma unroll
                for (int j = 0; j < 4; ++j) v[r][j] = (f32x4){0.f, 0.f, 0.f, 0.f};
            } }
#pragma unroll
        for (int r = 0; r < 2; ++r) { const int row = row0 + r * NGW;
            if (row < nrows) {
                const int bi = row < MLAT ? (row >> 13) : 8;
                float* xp = row < MLAT ? p.out + (size_t)row * 1024 : xc + (size_t)(row - MLAT) * 1024;
                if (first) {
                    if (row < MLAT) { bf16_t* xb = (bf16_t*)p.out + (size_t)row * 2048;
#pragma unroll
                        for (int j = 0; j < 4; ++j) { u32x2 o; o.x = cvt_pk_bf16(v[r][j][0], v[r][j][1]); o.y = cvt_pk_bf16(v[r][j][2], v[r][j][3]); *(u32x2*)(xb + 256 * j + 4 * lane) = o; }
                    } else {
#pragma unroll
                        for (int j = 0; j < 4; ++j) *(f32x4*)(xp + 256 * j + 4 * lane) = v[r][j];
                    }
                }
                float ss = 0.f;
#pragma unroll
                for (int j = 0; j < 4; ++j) ss += (v[r][j][0] * v[r][j][0] + v[r][j][1] * v[r][j][1]) + (v[r][j][2] * v[r][j][2] + v[r][j][3] * v[r][j][3]);
                ss = wave_sum(ss);
                const float rstd = rsqrtf(ss * (1.0f / 1024.0f) + EPS);
                const float* sh = modl + bi * 6144; const float* sc = sh + 1024;
#pragma unroll
                for (int j = 0; j < 4; ++j) { const int c = 256 * j + 4 * lane; const f32x4 w4 = *(const f32x4*)(nw + c), s4 = *(const f32x4*)(sh + c), c4 = *(const f32x4*)(sc + c);
                    const f32x4 h = v[r][j] * rstd * w4 * (c4 + 1.0f) + s4; u32x2 o; o.x = cvt_pk_bf16(h[0], h[1]); o.y = cvt_pk_bf16(h[2], h[3]);
                    *(u32x2*)(H + (size_t)row * 1024 + c) = o; }
            } }
    }
}

__device__ __forceinline__ void tables_phase(const Params& p, LAS unsigned char* lds) {
    const int tid = threadIdx.x, lane = tid & 63, w = __builtin_amdgcn_readfirstlane(tid >> 6);
    unsigned char* ws = p.ws;
    const float* mod = (const float*)(ws + OFF_MOD);
    float* GN = (float*)(ws + OFF_GN); float* SHB = (float*)(ws + OFF_SHB);
    const int gt = blockIdx.x * 512 + tid, NT = gridDim.x * 512;
    for (int i = gt; i < 3 * 9216; i += NT) { const int n = i / 9216, r = i % 9216, b = r >> 10, k = r & 1023; const int layer = n == 0 ? 0 : 1, which = n == 1 ? 0 : 1;
        GN[i] = p.in[which ? 7 : 6][layer * 1024 + k] * (1.0f + mod[(layer * 9 + b) * 6144 + (which ? 4 : 1) * 1024 + k]); }
    LAS float* sS = (LAS float*)lds;
    for (int it = blockIdx.x; it < 256; it += gridDim.x) {
        int n, r0; const bf16_t* wt; const float* sh;
        if (it < 88) { n = 0; r0 = it * 64; wt = (const bf16_t*)(ws + W_FFIN) + (size_t)r0 * 1024; sh = mod + 3 * 1024; }
        else if (it < 168) { n = 1; r0 = (it - 88) * 64; wt = (const bf16_t*)(ws + W_HGIN) + (size_t)r0 * 1024; sh = mod + 9 * 6144; }
        else { n = 2; r0 = (it - 168) * 64; wt = (const bf16_t*)(ws + W_FFIN) + (size_t)(5632 + r0) * 1024; sh = mod + 9 * 6144 + 3 * 1024; }
        __syncthreads();
        for (int i = tid; i < 9216; i += 512) sS[i] = sh[(i >> 10) * 6144 + (i & 1023)];
        __syncthreads();
        u32x4 wv[8][2];
#pragma unroll
        for (int j = 0; j < 8; ++j) { const bf16_t* wr_ = wt + (size_t)(w * 8 + j) * 1024 + lane * 16; wv[j][0] = *(const u32x4*)wr_; wv[j][1] = *(const u32x4*)(wr_ + 8); }
        for (int b = 0; b < 9; ++b) {
            f32x4 s4[4];
#pragma unroll
            for (int i = 0; i < 4; ++i) s4[i] = *(const LAS f32x4*)(sS + b * 1024 + lane * 16 + 4 * i);
#pragma unroll
            for (int j = 0; j < 8; ++j) { float d = 0.f;
#pragma unroll
                for (int i = 0; i < 4; ++i) { const unsigned a0 = wv[j][i >> 1][(i & 1) * 2], a1 = wv[j][i >> 1][(i & 1) * 2 + 1];
                    d += (bflo(a0) * s4[i][0] + bfhi(a0) * s4[i][1]) + (bflo(a1) * s4[i][2] + bfhi(a1) * s4[i][3]); }
                d = wave_sum(d);
                if (lane == 0) SHB[(n * 9 + b) * 5632 + r0 + w * 8 + j] = d; }
        }
    }
}

__device__ __forceinline__ void final_phase(const Params& p) {
    const int lane = threadIdx.x & 63, w = __builtin_amdgcn_readfirstlane(threadIdx.x >> 6);
    const int gw = blockIdx.x * 8 + w, NGW = gridDim.x * 8;
    const float* fw = p.in[21];
    f32x4 w4[4];
#pragma unroll
    for (int j = 0; j < 4; ++j) w4[j] = *(const f32x4*)(fw + lane * 16 + 4 * j);
    for (int row0 = gw; row0 < MLAT; row0 += 2 * NGW) {
        u32x4 a[2][2];
#pragma unroll
        for (int r = 0; r < 2; ++r) { const int row = row0 + r * NGW; const bf16_t* xb = (const bf16_t*)p.out + (size_t)(row < MLAT ? row : row0) * 2048 + lane * 16;
            a[r][0] = *(const u32x4*)xb; a[r][1] = *(const u32x4*)(xb + 8); }
        asm volatile("s_waitcnt vmcnt(0)" ::: "memory");
#pragma unroll
        for (int r = 0; r < 2; ++r) { const int row = row0 + r * NGW;
            if (row < MLAT) {
                f32x4 v[4];
                v[0] = (f32x4){bflo(a[r][0].x), bfhi(a[r][0].x), bflo(a[r][0].y), bfhi(a[r][0].y)}; v[1] = (f32x4){bflo(a[r][0].z), bfhi(a[r][0].z), bflo(a[r][0].w), bfhi(a[r][0].w)};
                v[2] = (f32x4){bflo(a[r][1].x), bfhi(a[r][1].x), bflo(a[r][1].y), bfhi(a[r][1].y)}; v[3] = (f32x4){bflo(a[r][1].z), bfhi(a[r][1].z), bflo(a[r][1].w), bfhi(a[r][1].w)};
                float ss = 0.f;
#pragma unroll
                for (int j = 0; j < 4; ++j) ss += (v[j][0] * v[j][0] + v[j][1] * v[j][1]) + (v[j][2] * v[j][2] + v[j][3] * v[j][3]);
                ss = wave_sum(ss); const float rstd = rsqrtf(ss * (1.0f / 1024.0f) + EPS);
                float* op = p.out + (size_t)row * 1024 + lane * 16;
#pragma unroll
                for (int j = 0; j < 4; ++j) *(f32x4*)(op + 4 * j) = v[j] * rstd * w4[j];
            } }
    }
}

__device__ __forceinline__ void spatial_phase(const Params& p, LAS unsigned char* lds) {
    const int tid = threadIdx.x, lane = tid & 63, w = __builtin_amdgcn_readfirstlane(tid >> 6), fr = lane & 15, fq = lane >> 4, wp = w >> 1, wcn = w & 1;
    bf16_t* U = (bf16_t*)(p.ws + OFF_U); const bf16_t* V = (const bf16_t*)(p.ws + OFF_V);
    const long long* stats = (const long long*)(p.ws + OFF_STATS); const bf16_t* Wsb = (const bf16_t*)(p.ws + W_WS);
    const float* lng = p.in[10]; const float* lnb = p.in[11]; const float* bs = p.in[13];
    LAS unsigned* VT = (LAS unsigned*)lds;
    const int ck = tid & 15, c = ck * 8, qp0 = tid >> 4;
    constexpr int NITEM = 528 * 24;
    u32x4 va[2], vb[2]; long long st[2][4]; f32x4 g0, g1, b0, b1;
    int item = blockIdx.x;
    if (item < NITEM) { const int ci = item / 24, sl = item % 24, r0 = ci * 128, c0 = sl * 128;
#pragma unroll
        for (int it = 0; it < 2; ++it) { const int q = (qp0 + it * 32) * 2; va[it] = *(const u32x4*)(V + (size_t)(r0 + q) * 3072 + c0 + c); vb[it] = *(const u32x4*)(V + (size_t)(r0 + q + 1) * 3072 + c0 + c);
            const long long* stp = stats + 2 * (r0 + q); st[it][0] = stp[0]; st[it][1] = stp[1]; st[it][2] = stp[2]; st[it][3] = stp[3]; }
        g0 = *(const f32x4*)(lng + c0 + c); g1 = *(const f32x4*)(lng + c0 + c + 4); b0 = *(const f32x4*)(lnb + c0 + c); b1 = *(const f32x4*)(lnb + c0 + c + 4); }
    for (; item < NITEM; item += gridDim.x) {
        const int ci = item / 24, sl = item % 24, g = sl / 3, r0 = ci * 128, c0 = sl * 128;
        bf16x8 Wf[2][4];
#pragma unroll
        for (int rt = 0; rt < 2; ++rt)
#pragma unroll
            for (int ks = 0; ks < 4; ++ks) Wf[rt][ks] = *(const bf16x8*)(Wsb + ((size_t)(g * 128 + wp * 32 + rt * 16 + fr) * 128 + ks * 32 + fq * 8));
        u32x4 uu[2][2]; float bsv[2];
#pragma unroll
        for (int rt = 0; rt < 2; ++rt) { const int pr = wp * 32 + rt * 16 + fr; bsv[rt] = bs[g * 128 + pr];
#pragma unroll
            for (int cp2 = 0; cp2 < 2; ++cp2) uu[rt][cp2] = *(const u32x4*)(U + (size_t)(r0 + pr) * 3072 + c0 + wcn * 64 + cp2 * 32 + fq * 8); }
#pragma unroll
        for (int it = 0; it < 2; ++it) {
            const int qp = qp0 + it * 32;
            const float FX = 1.0f / (1048576.0f * 3072.0f);
            const float mu0 = (float)st[it][0] * FX, mu1 = (float)st[it][2] * FX;
            const float rs0 = __builtin_amdgcn_rsqf(fmaxf((float)st[it][1] * FX - mu0 * mu0, 0.f) + EPS), rs1 = __builtin_amdgcn_rsqf(fmaxf((float)st[it][3] * FX - mu1 * mu1, 0.f) + EPS);
            const float nm0 = -mu0 * rs0, nm1 = -mu1 * rs1;
#pragma unroll
            for (int i = 0; i < 8; ++i) {
                const unsigned wa = va[it][i >> 1], wb = vb[it][i >> 1];
                const float xa = (i & 1) ? bfhi(wa) : bflo(wa), xb = (i & 1) ? bfhi(wb) : bflo(wb);
                const float gg = i < 4 ? g0[i & 3] : g1[i & 3], bb = i < 4 ? b0[i & 3] : b1[i & 3];
                VT[(c + i) * 68 + (qp ^ (4 * ck))] = cvt_pk_bf16((xa * rs0 + nm0) * gg + bb, (xb * rs1 + nm1) * gg + bb);
            }
        }
        __syncthreads();
        { const int nitem = item + gridDim.x;
            if (nitem < NITEM) { const int nci = nitem / 24, nsl = nitem % 24, nr0 = nci * 128, nc0 = nsl * 128;
#pragma unroll
                for (int it = 0; it < 2; ++it) { const int q = (qp0 + it * 32) * 2; va[it] = *(const u32x4*)(V + (size_t)(nr0 + q) * 3072 + nc0 + c); vb[it] = *(const u32x4*)(V + (size_t)(nr0 + q + 1) * 3072 + nc0 + c);
                    const long long* stp = stats + 2 * (nr0 + q); st[it][0] = stp[0]; st[it][1] = stp[1]; st[it][2] = stp[2]; st[it][3] = stp[3]; }
                g0 = *(const f32x4*)(lng + nc0 + c); g1 = *(const f32x4*)(lng + nc0 + c + 4); b0 = *(const f32x4*)(lnb + nc0 + c); b1 = *(const f32x4*)(lnb + nc0 + c + 4); } }
        f32x4 acc[2][4];
#pragma unroll
        for (int rt = 0; rt < 2; ++rt)
#pragma unroll
            for (int ct = 0; ct < 4; ++ct) acc[rt][ct] = (f32x4){0.f, 0.f, 0.f, 0.f};
#pragma unroll
        for (int ks = 0; ks < 4; ++ks)
#pragma unroll
            for (int ct = 0; ct < 4; ++ct) {
                const int crow = wcn * 64 + (ct >> 1) * 32 + 8 * (fr >> 2) + 4 * (ct & 1) + (fr & 3);
                const bf16x8 Bf = *(const LAS bf16x8*)(lds + crow * 272 + (((ks * 16 + fq * 4) ^ (4 * ((crow >> 3) & 15))) * 4));
#pragma unroll
                for (int rt = 0; rt < 2; ++rt) acc[rt][ct] = MFMA16(Bf, Wf[rt][ks], acc[rt][ct]);
            }
#pragma unroll
        for (int rt = 0; rt < 2; ++rt) { const int pr = wp * 32 + rt * 16 + fr;
#pragma unroll
            for (int cp2 = 0; cp2 < 2; ++cp2) { bf16_t* up = U + (size_t)(r0 + pr) * 3072 + c0 + wcn * 64 + cp2 * 32 + fq * 8; const u32x4 u4 = uu[rt][cp2];
                const f32x2 ga = gelu_pk((f32x2){bflo(u4.x), bfhi(u4.x)}), gb = gelu_pk((f32x2){bflo(u4.y), bfhi(u4.y)}), gc = gelu_pk((f32x2){bflo(u4.z), bfhi(u4.z)}), gd = gelu_pk((f32x2){bflo(u4.w), bfhi(u4.w)});
                const f32x4 a0 = acc[rt][2 * cp2] + bsv[rt], a1 = acc[rt][2 * cp2 + 1] + bsv[rt];
                u32x4 o; o.x = cvt_pk_bf16(a0[0] * ga.x, a0[1] * ga.y); o.y = cvt_pk_bf16(a0[2] * gb.x, a0[3] * gb.y); o.z = cvt_pk_bf16(a1[0] * gc.x, a1[1] * gc.y); o.w = cvt_pk_bf16(a1[2] * gd.x, a1[3] * gd.y);
                *(u32x4*)up = o; } }
        __syncthreads();
    }
}

__device__ __forceinline__ int scan_base(int c, int b, int dir) {
    return c < 4 ? (MLAT + b * 256 + (dir ? 255 - c * 64 : c * 64)) : (b * 8192 + (dir ? 8191 - (c - 4) * 64 : (c - 4) * 64));
}
__device__ __forceinline__ void scan_phase(const Params& p, LAS unsigned char* lds) {
    const int tid = threadIdx.x, lane = tid & 63, w = __builtin_amdgcn_readfirstlane(tid >> 6), fr = lane & 15, fq = lane >> 4;
    constexpr int SET = 62976, oKI = 17408, oKDT = 34816, oVT = 53248, oDD = 62464;
    LAS unsigned char* ATT = lds + 125952; LAS unsigned char* ST = lds + 135168; LAS float* SEGT = (LAS float*)(lds + 152576);
    const bf16_t* sec0 = (const bf16_t*)(p.ws + OFF_U);
    bf16_t* OF = (bf16_t*)(p.ws + OFF_V + 2 * SEC); bf16_t* OB = (bf16_t*)(p.ws + OFF_H);
    const int cp = tid & 63, seg = tid >> 6, dvv = tid & 63, ts = tid >> 6;
#define SCAN_LOAD(cc) do { const int _b = scan_base((cc), b, dir); _Pragma("unroll") for (int i = 0; i < 8; ++i) { const int row = _b + sgn * (seg * 8 + i); \
        rq[i] = *(const unsigned*)(Qp + (size_t)row * 1024); rk[i] = *(const unsigned*)(Kp + (size_t)row * 1024); rv[i] = Vp[(size_t)row * 1024]; } } while (0)
#define SCAN_UNPACK() do { _Pragma("unroll") for (int i = 0; i < 8; ++i) { q0[i] = bflo(rq[i]); q1[i] = bfhi(rq[i]); k0[i] = bflo(rk[i]); k1[i] = bfhi(rk[i]); } \
        vpk.x = (unsigned)rv[0] | ((unsigned)rv[1] << 16); vpk.y = (unsigned)rv[2] | ((unsigned)rv[3] << 16); vpk.z = (unsigned)rv[4] | ((unsigned)rv[5] << 16); vpk.w = (unsigned)rv[6] | ((unsigned)rv[7] << 16); } while (0)
#define SCAN_P1() do { float r0 = 1.f, r1 = 1.f; _Pragma("unroll") for (int i = 0; i < 8; ++i) { r0 *= (1.0f - k0[i]); r1 *= (1.0f - k1[i]); c0[i] = r0; c1[i] = r1; } \
        *(LAS f32x2*)(SEGT + seg * 128 + 2 * cp) = (f32x2){r0, r1}; } while (0)
#define SCAN_P2(so) do { LAS unsigned char* _QD = lds + (so); LAS unsigned char* _KI = _QD + oKI; LAS unsigned char* _KDT = _QD + oKDT; LAS unsigned char* _VT = _QD + oVT; LAS float* _DD = (LAS float*)(_QD + oDD); \
        float of0 = 1.f, of1 = 1.f, tt0 = 1.f, tt1 = 1.f; \
        _Pragma("unroll") for (int s_ = 0; s_ < 8; ++s_) { const f32x2 t = *(const LAS f32x2*)(SEGT + s_ * 128 + 2 * cp); tt0 *= t.x; tt1 *= t.y; of0 *= (s_ < seg) ? t.x : 1.f; of1 *= (s_ < seg) ? t.y : 1.f; } \
        unsigned kda[4], kdb[4]; \
        _Pragma("unroll") for (int i = 0; i < 8; i += 2) { float kd0[2], kd1[2]; \
            _Pragma("unroll") for (int e = 0; e < 2; ++e) { const float e0 = of0 * c0[i + e], e1 = of1 * c1[i + e]; const float r0 = __builtin_amdgcn_rcpf(e0), r1 = __builtin_amdgcn_rcpf(e1); const int t = seg * 8 + i + e; \
                *(LAS unsigned*)(_QD + (t * 136 + 2 * cp) * 2) = cvt_pk_bf16(q0[i + e] * e0, q1[i + e] * e1); \
                *(LAS unsigned*)(_KI + (t * 136 + 2 * cp) * 2) = cvt_pk_bf16(k0[i + e] * r0, k1[i + e] * r1); \
                kd0[e] = k0[i + e] * (tt0 * r0); kd1[e] = k1[i + e] * (tt1 * r1); } \
            kda[i >> 1] = cvt_pk_bf16(kd0[0], kd0[1]); kdb[i >> 1] = cvt_pk_bf16(kd1[0], kd1[1]); } \
        *(LAS u32x4*)(_KDT + ((2 * cp) * 72 + seg * 8) * 2) = (u32x4){kda[0], kda[1], kda[2], kda[3]}; \
        *(LAS u32x4*)(_KDT + ((2 * cp + 1) * 72 + seg * 8) * 2) = (u32x4){kdb[0], kdb[1], kdb[2], kdb[3]}; \
        if (seg == 0) *(LAS f32x2*)(_DD + 2 * cp) = (f32x2){tt0, tt1}; \
        *(LAS u32x4*)(_VT + (dvv * 72 + ts * 8) * 2) = vpk; } while (0)
    for (int chain = blockIdx.x; chain < 256; chain += gridDim.x) {
        const int vh = chain & 1, dir = (chain >> 1) & 1, h = (chain >> 2) & 7, b = chain >> 5;
        const bf16_t* Qp = sec0 + h * 128 + 2 * cp;
        const bf16_t* Kp = sec0 + (size_t)(1 + dir) * SECE + h * 128 + 2 * cp;
        const bf16_t* Vp = sec0 + (size_t)3 * SECE + h * 128 + vh * 64 + dvv;
        bf16_t* Op = (dir ? OB : OF) + h * 128 + vh * 64;
        const int sgn = dir ? -1 : 1;
        f32x4 S[4];
#pragma unroll
        for (int i = 0; i < 4; ++i) S[i] = (f32x4){0.f, 0.f, 0.f, 0.f};
        for (int i = tid; i < 4352; i += 512) ((LAS unsigned*)ST)[i] = 0u;
        unsigned rq[8], rk[8]; unsigned short rv[8];
        float q0[8], q1[8], k0[8], k1[8], c0[8], c1[8]; u32x4 vpk;
        SCAN_LOAD(0);
        SCAN_UNPACK();
        SCAN_LOAD(1);
        SCAN_P1();
        __syncthreads();
        SCAN_P2(0);
        __syncthreads();
        for (int c = 0; c < 132; ++c) {
            const int base = scan_base(c, b, dir);
            const int so = (c & 1) * SET;
            LAS unsigned char* QD = lds + so; LAS unsigned char* KI = QD + oKI; LAS unsigned char* KDT = QD + oKDT; LAS unsigned char* VT = QD + oVT; LAS float* DD = (LAS float*)(QD + oDD);
            if (c > 0) {
#pragma unroll
                for (int dt = 0; dt < 4; ++dt) { u32x2 o; o.x = cvt_pk_bf16(S[dt][0], S[dt][1]); o.y = cvt_pk_bf16(S[dt][2], S[dt][3]);
                    *(LAS u32x2*)(ST + ((dt * 16 + fr) * 136 + w * 16 + fq * 4) * 2) = o; }
            }
            if (c + 1 < 132) { SCAN_UNPACK(); if (c + 2 < 132) SCAN_LOAD(c + 2); SCAN_P1(); }
            bf16x8 qf[4];
            { const int ti = w >> 1;
#pragma unroll
                for (int ks = 0; ks < 4; ++ks) qf[ks] = *(const LAS bf16x8*)(QD + ((ti * 16 + fr) * 136 + ks * 32 + fq * 8) * 2);
#pragma unroll
                for (int sj = 0; sj < 2; ++sj) { const int si = (w & 1) * 2 + sj; f32x4 a = (f32x4){0.f, 0.f, 0.f, 0.f};
                    if (si <= ti) {
#pragma unroll
                        for (int ks = 0; ks < 4; ++ks) { const bf16x8 X = *(const LAS bf16x8*)(KI + ((si * 16 + fr) * 136 + ks * 32 + fq * 8) * 2);
                            a = MFMA16(X, qf[ks], a); }
                        const int tg = ti * 16 + fr, sg = si * 16 + fq * 4;
#pragma unroll
                        for (int j = 0; j < 4; ++j) a[j] = (sg + j <= tg) ? a[j] : 0.f;
                    }
                    u32x2 o; o.x = cvt_pk_bf16(a[0], a[1]); o.y = cvt_pk_bf16(a[2], a[3]);
                    *(LAS u32x2*)(ATT + ((ti * 16 + fr) * 72 + si * 16 + fq * 4) * 2) = o; } }
            __syncthreads();
            if (c + 1 < 132) SCAN_P2(SET - so);
            { const int ti = w >> 1;
#pragma unroll
                for (int dj = 0; dj < 2; ++dj) { const int di = (w & 1) * 2 + dj; f32x4 a = (f32x4){0.f, 0.f, 0.f, 0.f};
#pragma unroll
                    for (int ks = 0; ks < 2; ++ks) { const bf16x8 X = *(const LAS bf16x8*)(VT + ((di * 16 + fr) * 72 + ks * 32 + fq * 8) * 2), Y = *(const LAS bf16x8*)(ATT + ((ti * 16 + fr) * 72 + ks * 32 + fq * 8) * 2);
                        a = MFMA16(X, Y, a); }
#pragma unroll
                    for (int ks = 0; ks < 4; ++ks) { const bf16x8 X = *(const LAS bf16x8*)(ST + ((di * 16 + fr) * 136 + ks * 32 + fq * 8) * 2);
                        a = MFMA16(X, qf[ks], a); }
                    if (c >= 4) { const int row = base + sgn * (ti * 16 + fr); u32x2 o; o.x = cvt_pk_bf16(a[0], a[1]); o.y = cvt_pk_bf16(a[2], a[3]);
                        *(u32x2*)(Op + (size_t)row * 1024 + di * 16 + fq * 4) = o; } } }
            { const f32x4 dd = *(const LAS f32x4*)(DD + w * 16 + fq * 4);
#pragma unroll
                for (int dt = 0; dt < 4; ++dt) { S[dt] = S[dt] * dd;
#pragma unroll
                    for (int ks = 0; ks < 2; ++ks) { const bf16x8 X = *(const LAS bf16x8*)(KDT + ((w * 16 + fr) * 72 + ks * 32 + fq * 8) * 2), Y = *(const LAS bf16x8*)(VT + ((dt * 16 + fr) * 72 + ks * 32 + fq * 8) * 2);
                        S[dt] = MFMA16(X, Y, S[dt]); } } }
            __syncthreads();
        }
    }
#undef SCAN_LOAD
#undef SCAN_UNPACK
#undef SCAN_P1
#undef SCAN_P2
}

__device__ __forceinline__ void readout_phase(const Params& p) {
    const int lane = threadIdx.x & 63, w = __builtin_amdgcn_readfirstlane(threadIdx.x >> 6);
    const int gw = blockIdx.x * 8 + w, NGW = gridDim.x * 8;
    const bf16_t* OF = (const bf16_t*)(p.ws + OFF_V + 2 * SEC); const bf16_t* OB = (const bf16_t*)(p.ws + OFF_H);
    const bf16_t* G = (const bf16_t*)(p.ws + OFF_U) + (size_t)4 * SECE; bf16_t* R = (bf16_t*)(p.ws + OFF_U);
    const float* nw = p.in[17];
    for (int row0 = gw; row0 < MLAT; row0 += 2 * NGW) {
        u32x4 a[2][2], b[2][2], g[2][2];
#pragma unroll
        for (int r = 0; r < 2; ++r) { const int row = row0 + r * NGW; const size_t o = (size_t)(row < MLAT ? row : row0) * 1024 + lane * 16;
#pragma unroll
            for (int i = 0; i < 2; ++i) { a[r][i] = *(const u32x4*)(OF + o + 8 * i); b[r][i] = *(const u32x4*)(OB + o + 8 * i); g[r][i] = *(const u32x4*)(G + o + 8 * i); } }
#pragma unroll
        for (int r = 0; r < 2; ++r) { const int row = row0 + r * NGW;
            if (row < MLAT) { const size_t o = (size_t)row * 1024 + lane * 16;
                float v[16]; float ss = 0.f;
#pragma unroll
                for (int i = 0; i < 8; ++i) { const unsigned wa = a[r][i >> 2][i & 3], wb = b[r][i >> 2][i & 3]; v[2 * i] = bflo(wa) + bflo(wb); v[2 * i + 1] = bfhi(wa) + bfhi(wb); ss += v[2 * i] * v[2 * i] + v[2 * i + 1] * v[2 * i + 1]; }
                ss += __shfl_xor(ss, 1); ss += __shfl_xor(ss, 2); ss += __shfl_xor(ss, 4);
                const float rstd = rsqrtf(ss * (1.0f / 128.0f) + EPS);
                u32x4 rr[2];
#pragma unroll
                for (int i = 0; i < 8; ++i) { const unsigned wg = g[r][i >> 2][i & 3]; const f32x2 n2 = *(const f32x2*)(nw + lane * 16 + 2 * i);
                    rr[i >> 2][i & 3] = cvt_pk_bf16(v[2 * i] * rstd * n2.x * bflo(wg), v[2 * i + 1] * rstd * n2.y * bfhi(wg)); }
                *(u32x4*)(R + o) = rr[0]; *(u32x4*)(R + o + 8) = rr[1]; } }
    }
}

#define XB_TMO      128
#define XB_XCNT(j)  (256  + 64 * (j))
#define XB_XSUB(j)  (1280 + 64 * (j))
#define XB_XGEN(j)  (2304 + 64 * (j))
#define XB_TOP      3328
#define XB_TOPGEN   3392
#define XB_SPIN_CAP (1u << 22)
__device__ __forceinline__ unsigned xb_ld(unsigned* p)              { return __hip_atomic_load(p, __ATOMIC_RELAXED, __HIP_MEMORY_SCOPE_AGENT); }
__device__ __forceinline__ unsigned xb_add(unsigned* p, unsigned v) { return __hip_atomic_fetch_add(p, v, __ATOMIC_RELAXED, __HIP_MEMORY_SCOPE_AGENT); }
__device__ __forceinline__ unsigned xb_xcc_id() { return (unsigned)__builtin_amdgcn_s_getreg((3 << 11) | 20) & 0xFu; }
#define XB_SPIN(cond, bar) do { unsigned _sp = 0; while (cond) { __builtin_amdgcn_s_sleep(1); \
    if ((++_sp & 255u) == 0u) { if (xb_ld(&(bar)[XB_TMO])) break; if (_sp > XB_SPIN_CAP) { atomicAdd(&(bar)[XB_TMO], 1u); break; } } } } while (0)
struct XcdBarrier { unsigned* bar; unsigned x; volatile LAS unsigned* st; };
__device__ __forceinline__ XcdBarrier xcd_barrier_post(unsigned* bar, volatile LAS unsigned* st) {
    XcdBarrier b; b.bar = bar; b.x = xb_xcc_id(); b.st = st;
    if (threadIdx.x == 0) (void)xb_add(&bar[XB_XCNT(b.x)], 1u);
    return b;
}
__device__ __forceinline__ void xcd_barrier_complete(unsigned* bar, unsigned x, unsigned& nloc, unsigned& nx) {
    const unsigned G = gridDim.x * gridDim.y * gridDim.z;
    unsigned sum, cnt, mine, sp = 0u;
    for (;;) {
        sum = 0u; cnt = 0u; mine = 0u;
#pragma unroll
        for (unsigned j = 0; j < 16; ++j) { const unsigned c = xb_ld(&bar[XB_XCNT(j)]); sum += c; cnt += (c > 0u) ? 1u : 0u; mine = (j == x) ? c : mine; }
        if (sum == G) break;
        __builtin_amdgcn_s_sleep(1);
        if ((++sp & 255u) == 0u) { if (xb_ld(&bar[XB_TMO])) break; if (sp > XB_SPIN_CAP) { atomicAdd(&bar[XB_TMO], 1u); break; } }
    }
    nloc = mine > 0u ? mine : 1u; nx = cnt > 0u ? cnt : 1u;
}
__device__ __forceinline__ void xcd_barrier(const XcdBarrier& b) {
    asm volatile("s_waitcnt vmcnt(0)" ::: "memory");
    __syncthreads();
    if (threadIdx.x == 0) {
        unsigned* bar = b.bar;
        __builtin_amdgcn_s_waitcnt(0);
        unsigned nloc = b.st[0], nx = b.st[1];
        if (nloc == 0u) { xcd_barrier_complete(bar, b.x, nloc, nx); b.st[0] = nloc; b.st[1] = nx; }
        const unsigned old = xb_add(&bar[XB_XSUB(b.x)], 1u);
        const unsigned gen = old / nloc;
        if (old + 1u == (gen + 1u) * nloc) {
            __builtin_amdgcn_fence(__ATOMIC_RELEASE, "agent");
            asm volatile("s_waitcnt vmcnt(0)" ::: "memory");
            const unsigned og = xb_add(&bar[XB_TOP], 1u);
            const unsigned tg = og / nx;
            if (og + 1u == (tg + 1u) * nx) xb_add(&bar[XB_TOPGEN], 1u);
            else XB_SPIN(xb_ld(&bar[XB_TOPGEN]) == tg, bar);
            __builtin_amdgcn_fence(__ATOMIC_ACQUIRE, "agent");
            xb_add(&bar[XB_XGEN(b.x)], 1u);
            asm volatile("s_waitcnt vmcnt(0)" ::: "memory");
        } else {
            XB_SPIN(xb_ld(&bar[XB_XGEN(b.x)]) == gen, bar);
            __builtin_amdgcn_fence(__ATOMIC_ACQUIRE, "agent");
            asm volatile("s_waitcnt vmcnt(0)" ::: "memory");
        }
    }
    __syncthreads();
}

__device__ __forceinline__ void ctx_gemm_phase(LAS unsigned char* lds, const bf16_t* A, const bf16_t* Wt, int K, const float* gate, const float* gn, unsigned long long* ssw, bf16_t* xg, float* xc) {
    const int tid = threadIdx.x, lane = tid & 63, w = __builtin_amdgcn_readfirstlane(tid >> 6), fr = lane & 15, fq = lane >> 4, wr = w >> 2, wc = w & 3;
    const int ns = K / 128;
    for (int t = blockIdx.x; t < 256; t += gridDim.x) {
        const int rt = t >> 3, ct = t & 7;
        const bf16_t* ag[2]; const bf16_t* bg[4]; int lofA[2], lofB[4];
#pragma unroll
        for (int q = 0; q < 2; ++q) { const int pz = tid + 512 * q, row = pz >> 4, c16 = pz & 15; ag[q] = A + (size_t)(rt * 64 + row) * K + c16 * 8; lofA[q] = row * 272 + c16 * 16; }
#pragma unroll
        for (int q = 0; q < 4; ++q) { const int pz = tid + 512 * q, row = pz >> 4, c16 = pz & 15; bg[q] = Wt + (size_t)(ct * 128 + row) * K + c16 * 8; lofB[q] = 17408 + row * 272 + c16 * 16; }
        f32x4 acc[2][2];
#pragma unroll
        for (int i = 0; i < 2; ++i)
#pragma unroll
            for (int j = 0; j < 2; ++j) acc[i][j] = (f32x4){0.f, 0.f, 0.f, 0.f};
        u32x4 r0[6], r1[6], r2[6];
#define CG_LD(R, S) do { _Pragma("unroll") for (int q = 0; q < 2; ++q) R[q] = *(const u32x4*)(ag[q] + (S) * 128); _Pragma("unroll") for (int q = 0; q < 4; ++q) R[2 + q] = *(const u32x4*)(bg[q] + (S) * 128); } while (0)
#define CG_ST(R, BUF) do { LAS unsigned char* _b = lds + (BUF) * 52224; _Pragma("unroll") for (int q = 0; q < 2; ++q) *(LAS u32x4*)(_b + lofA[q]) = R[q]; _Pragma("unroll") for (int q = 0; q < 4; ++q) *(LAS u32x4*)(_b + lofB[q]) = R[2 + q]; } while (0)
#define CG_MM(BUF) do { const LAS unsigned char* _b = lds + (BUF) * 52224; _Pragma("unroll") for (int u = 0; u < 4; ++u) { bf16x8 Af[2], Bf[2]; \
            _Pragma("unroll") for (int i = 0; i < 2; ++i) { Af[i] = *(const LAS bf16x8*)(_b + (wr * 32 + i * 16 + fr) * 272 + (u * 32 + fq * 8) * 2); Bf[i] = *(const LAS bf16x8*)(_b + 17408 + (wc * 32 + i * 16 + fr) * 272 + (u * 32 + fq * 8) * 2); } \
            _Pragma("unroll") for (int i = 0; i < 2; ++i) _Pragma("unroll") for (int j = 0; j < 2; ++j) acc[i][j] = MFMA16(Bf[j], Af[i], acc[i][j]); } } while (0)
        CG_LD(r0, 0); CG_LD(r1, 1); CG_LD(r2, 2);
        CG_ST(r0, 0);
        __syncthreads();
        for (int s0 = 0; s0 < ns; s0 += 3) {
            { if (s0 + 1 < ns) CG_ST(r1, (s0 + 1) & 1); if (s0 + 3 < ns) CG_LD(r0, s0 + 3); CG_MM(s0 & 1); __syncthreads(); }
            if (s0 + 1 < ns) { if (s0 + 2 < ns) CG_ST(r2, (s0 + 2) & 1); if (s0 + 4 < ns) CG_LD(r1, s0 + 4); CG_MM((s0 + 1) & 1); __syncthreads(); }
            if (s0 + 2 < ns) { if (s0 + 3 < ns) CG_ST(r0, (s0 + 3) & 1); if (s0 + 5 < ns) CG_LD(r2, s0 + 5); CG_MM((s0 + 2) & 1); __syncthreads(); }
        }
#undef CG_LD
#undef CG_ST
#undef CG_MM
        f32x4 xin[2][2], gvv[2], gnn[2];
#pragma unroll
        for (int j = 0; j < 2; ++j) { const int c = ct * 128 + wc * 32 + j * 16 + fq * 4; gvv[j] = *(const f32x4*)(gate + c); gnn[j] = *(const f32x4*)(gn + c);
#pragma unroll
            for (int i = 0; i < 2; ++i) xin[i][j] = *(const f32x4*)(xc + (size_t)(rt * 64 + wr * 32 + i * 16 + fr) * 1024 + c); }
#pragma unroll
        for (int i = 0; i < 2; ++i) { const int r = rt * 64 + wr * 32 + i * 16 + fr; float ss = 0.f;
#pragma unroll
            for (int j = 0; j < 2; ++j) { const int c = ct * 128 + wc * 32 + j * 16 + fq * 4;
                const f32x4 gv = gvv[j], gnv = gnn[j];
                f32x4 x = xin[i][j] + gv * acc[i][j]; *(f32x4*)(xc + (size_t)r * 1024 + c) = x;
                ss += (x[0] * x[0] + x[1] * x[1]) + (x[2] * x[2] + x[3] * x[3]);
                const f32x4 y = x * gnv; u32x2 o; o.x = cvt_pk_bf16(y[0], y[1]); o.y = cvt_pk_bf16(y[2], y[3]); *(u32x2*)(xg + (size_t)r * 1024 + c) = o; }
            ss += __shfl_xor(ss, 16); ss += __shfl_xor(ss, 32);
            if (fq == 0) atomicAdd(ssw + r, (unsigned long long)(long long)llrintf(ss * 1048576.0f)); }
    }
}

__global__ void __launch_bounds__(512, 2) fwd_kernel(Params p) {
    extern __shared__ __attribute__((aligned(16))) unsigned char lds_raw[];
    LAS unsigned char* lds = (LAS unsigned char*)lds_raw;
    unsigned char* ws = p.ws;
    const int lo = p.ph_lo, hi = p.ph_hi;
    volatile LAS unsigned* bst = (volatile LAS unsigned*)(lds + BST_OFF);
    if (threadIdx.x < 2) bst[threadIdx.x] = 0u;
    __syncthreads();
    XcdBarrier bar; bar.bar = (unsigned*)(ws + OFF_BAR); bar.x = 0; bar.st = bst;
    if (hi - lo > 1) bar = xcd_barrier_post((unsigned*)(ws + OFF_BAR), bst);
#define IN(k) (lo <= (k) && (k) < hi)
#define SEAM(k) do { if (IN(k) && hi - lo > 1) { if ((k) == 0) cg::this_grid().sync(); else xcd_barrier(bar); if (DUP(20)) { xcd_barrier(bar); xcd_barrier(bar); } } } while (0)
#define MODP ((const float*)(ws + OFF_MOD))
#define GEMM_RUN(E, A_, B_, M_, N_, K_) do { StaticOrder S; S.init((M_), (N_), (int)gridDim.x, (int)blockIdx.x); gemm_phase(lds, (const bf16_t*)(A_), (const bf16_t*)(B_), (M_), (N_), (K_), S, E); } while (0)
    if (IN(0)) { prep_phase(p, lds); if (DUP(0)) { __syncthreads(); prep_phase(p, lds); } }
    SEAM(0);
    if (IN(1)) { modrms_phase(p, 0, 0, MALL, true); tables_phase(p, lds); if (DUP(1)) { __syncthreads(); modrms_phase(p, 0, 0, MALL, true); tables_phase(p, lds); } }
    SEAM(1);
    if (IN(2)) { Epi<1> E{}; E.U = (bf16_t*)(ws + OFF_U); E.V = (bf16_t*)(ws + OFF_V); E.bias = p.in[9]; E.stats = (unsigned long long*)(ws + OFF_STATS);
        GEMM_RUN(E, ws + OFF_H, ws + W_GMIN, MALL, 6144, 1024); }
    SEAM(2);
    if (IN(3)) spatial_phase(p, lds);
    SEAM(3);
    if (IN(4)) { Epi<2> E{}; E.xlat = p.out; E.xctx = (float*)(ws + OFF_XC); E.gate = MODP + 2 * 1024;
        E.xg = (bf16_t*)(ws + OFF_H); E.gn = (const float*)(ws + OFF_GN); E.ssw = (unsigned long long*)(ws + OFF_SS);
        ctx_gemm_phase(lds, (const bf16_t*)(ws + OFF_U) + (size_t)MLAT * 3072, (const bf16_t*)(ws + W_GMOUT), 3072, MODP + 2 * 1024 + 8 * 6144, (const float*)(ws + OFF_GN) + 8 * 1024,
                       (unsigned long long*)(ws + OFF_SS) + MLAT, (bf16_t*)(ws + OFF_H) + (size_t)MLAT * 1024, (float*)(ws + OFF_XC));
        GEMM_RUN(E, ws + OFF_U, ws + W_GMOUT, MLAT, 1024, 3072); }
    SEAM(4);
    if (IN(6)) { Epi<3> E{}; E.hid = (bf16_t*)(ws + OFF_U); E.ssr = (const long long*)(ws + OFF_SS); E.shb = (const float*)(ws + OFF_SHB); E.shn = 5632;
        GEMM_RUN(E, ws + OFF_H, ws + W_FFIN, MALL, 5632, 1024); if (DUP(6)) GEMM_RUN(E, ws + OFF_H, ws + W_FFIN, MALL, 5632, 1024); }
    SEAM(6);
    if (IN(7)) { Epi<2> E{}; E.xlat = p.out; E.xctx = (float*)(ws + OFF_XC); E.gate = MODP + 5 * 1024;
        E.xg = (bf16_t*)(ws + OFF_H); E.gn = (const float*)(ws + OFF_GN) + 9216; E.ssw = (unsigned long long*)(ws + OFF_SS) + MALL;
        ctx_gemm_phase(lds, (const bf16_t*)(ws + OFF_U) + (size_t)MLAT * 2816, (const bf16_t*)(ws + W_FFOUT), 2816, MODP + 5 * 1024 + 8 * 6144, (const float*)(ws + OFF_GN) + 9216 + 8 * 1024,
                       (unsigned long long*)(ws + OFF_SS) + MALL + MLAT, (bf16_t*)(ws + OFF_H) + (size_t)MLAT * 1024, (float*)(ws + OFF_XC));
        GEMM_RUN(E, ws + OFF_U, ws + W_FFOUT, MLAT, 1024, 2816); }
    SEAM(7);
    if (IN(9)) { Epi<4> E{}; E.proj = (bf16_t*)(ws + OFF_U); E.lbtab = (const float*)(ws + OFF_LB); E.ssr = (const long long*)(ws + OFF_SS) + MALL; E.shb = (const float*)(ws + OFF_SHB) + 9 * 5632; E.shn = 5632;
        GEMM_RUN(E, ws + OFF_H, ws + W_HGIN, MALL, 5120, 1024); }
    SEAM(9);
    if (IN(10)) { scan_phase(p, lds); if (DUP(10)) scan_phase(p, lds); }
    SEAM(10);
    if (IN(11)) { readout_phase(p); if (DUP(11)) readout_phase(p); }
    SEAM(11);
    if (IN(12)) { Epi<2> E{}; E.xlat = p.out; E.xctx = (float*)(ws + OFF_XC); E.gate = MODP + 9 * 6144 + 2 * 1024;
        E.xg = (bf16_t*)(ws + OFF_H); E.gn = (const float*)(ws + OFF_GN) + 2 * 9216; E.ssw = (unsigned long long*)(ws + OFF_SS) + 2 * MALL;
        GEMM_RUN(E, ws + OFF_U, ws + W_HGOUT, MLAT, 1024, 1024); }
    SEAM(12);
    if (IN(14)) { Epi<3> E{}; E.hid = (bf16_t*)(ws + OFF_U); E.ssr = (const long long*)(ws + OFF_SS) + 2 * MALL; E.shb = (const float*)(ws + OFF_SHB) + 2 * 9 * 5632; E.shn = 5632;
        GEMM_RUN(E, ws + OFF_H, ws + W_FFIN + (size_t)5632 * 1024 * 2, MLAT, 5632, 1024); }
    SEAM(14);
    if (IN(15)) { Epi<5> E{}; E.xlat = p.out; E.xctx = (float*)(ws + OFF_XC); E.gate = MODP + 9 * 6144 + 5 * 1024;
        GEMM_RUN(E, ws + OFF_U, ws + W_FFOUT + (size_t)1024 * 2816 * 2, MLAT, 1024, 2816); }
    SEAM(15);
    if (IN(16)) final_phase(p);
#undef IN
#undef SEAM
}

extern "C" void kernel_launch(void* const* d_in, const int* in_sizes, int n_in, void* d_out, int out_size, void* d_ws, size_t ws_size, hipStream_t stream) {
    static int grid = 0;
    if (grid == 0) {
        if (n_in != 22 || ws_size < WS_END) { fprintf(stderr, "kernel_launch: unexpected n_in %d / ws_size %zu (need %zu)\n", n_in, ws_size, (size_t)WS_END); grid = -1; return; }
        int dev = 0, cus = 0, per_cu = 0;
        (void)hipGetDevice(&dev); (void)hipDeviceGetAttribute(&cus, hipDeviceAttributeMultiprocessorCount, dev);
        if (hipFuncSetAttribute((const void*)fwd_kernel, hipFuncAttributeMaxDynamicSharedMemorySize, LDS_BYTES) != hipSuccess) { fprintf(stderr, "kernel_launch: hipFuncSetAttribute failed\n"); grid = -1; return; }
        (void)hipOccupancyMaxActiveBlocksPerMultiprocessor(&per_cu, (const void*)fwd_kernel, 512, LDS_BYTES);
        (void)hipGetLastError();
        if (per_cu < 1) per_cu = 1;
        grid = cus * 1;
        if (grid <= 0) grid = 256;
    }
    if (grid < 0) return;
    Params p{};
    for (int i = 0; i < 22; ++i) p.in[i] = (const float*)d_in[i];
    p.out = (float*)d_out; p.ws = (unsigned char*)d_ws;
#if COOP
    if (hipMemsetAsync((char*)d_ws + OFF_BAR, 0, 16384, stream) != hipSuccess) { fprintf(stderr, "kernel_launch: memset of the barrier words failed\n"); return; }
    p.ph_lo = 0; p.ph_hi = NPHASE;
    void* args[] = {&p};
    hipError_t e = hipLaunchCooperativeKernel((const void*)fwd_kernel, dim3(grid), dim3(512), args, LDS_BYTES, stream);
    if (e != hipSuccess) fprintf(stderr, "cooperative launch failed: %s (grid %d)\n", hipGetErrorString(e), grid);
#else
    for (int ph = 0; ph < NPHASE; ++ph) { p.ph_lo = ph; p.ph_hi = ph + 1; hipLaunchKernelGGL(fwd_kernel, dim3(grid), dim3(512), LDS_BYTES, stream, p); }
#endif
}
```

```cpp
#include <hip/hip_runtime.h>
#include <hip/hip_cooperative_groups.h>
#include <cstdio>
namespace cg = cooperative_groups;

#ifndef COOP
#define COOP 1
#endif

#ifndef PROBE_MASK
#define PROBE_MASK 0
#endif
#define DUP(k) ((PROBE_MASK >> (k)) & 1)
#define LAS __attribute__((address_space(3)))
typedef unsigned short bf16_t;
typedef short bf16x8 __attribute__((ext_vector_type(8)));
typedef float f32x4 __attribute__((ext_vector_type(4)));
typedef float f32x2 __attribute__((ext_vector_type(2)));
typedef unsigned u32x4 __attribute__((ext_vector_type(4)));
typedef unsigned u32x2 __attribute__((ext_vector_type(2)));

constexpr int MLAT = 65536, MCTX = 2048, MALL = 67584;
constexpr float EPS = 1e-6f;
constexpr int NPHASE = 17;
constexpr int XOFF = 131072 + 64;
constexpr int LDS_BYTES = 163840;
constexpr int BST_OFF = 163840 - 64;

constexpr size_t SECE = (size_t)MALL * 1024;
constexpr size_t SEC = SECE * 2;
constexpr size_t OFF_XC = 0;
constexpr size_t OFF_H = 8388608;
constexpr size_t OFF_U = OFF_H + SEC;
constexpr size_t OFF_V = OFF_U + 3 * SEC;
constexpr size_t OFF_W = OFF_V + 3 * SEC;
constexpr size_t W_GMIN = OFF_W;
constexpr size_t W_GMOUT = W_GMIN + (size_t)6144 * 1024 * 2;
constexpr size_t W_HGIN = W_GMOUT + (size_t)1024 * 3072 * 2;
constexpr size_t W_HGOUT = W_HGIN + (size_t)5120 * 1024 * 2;
constexpr size_t W_FFIN = W_HGOUT + (size_t)1024 * 1024 * 2;
constexpr size_t W_FFOUT = W_FFIN + (size_t)2 * 5632 * 1024 * 2;
constexpr size_t W_WS = W_FFOUT + (size_t)2 * 1024 * 2816 * 2;
constexpr size_t OFF_MOD = W_WS + (size_t)8 * 128 * 128 * 2;
constexpr size_t OFF_STATS = OFF_MOD + (size_t)2 * 9 * 6144 * 4;
constexpr size_t OFF_POS = OFF_STATS + (size_t)MALL * 2 * 8;
constexpr size_t OFF_LB = OFF_POS + (size_t)192 * 512 * 4;
constexpr size_t OFF_SS = OFF_LB + 2048 * 4;
constexpr size_t OFF_SHB = OFF_SS + (size_t)3 * MALL * 8;
constexpr size_t OFF_GN = OFF_SHB + (size_t)3 * 9 * 5632 * 4;
constexpr size_t OFF_BAR = OFF_GN + (size_t)3 * 9 * 1024 * 4;
constexpr size_t BAR_BYTES = 3456 * 4;
constexpr size_t WS_END = OFF_BAR + 16384;

struct Params { const float* in[22]; float* out; unsigned char* ws; int ph_lo, ph_hi; };

typedef __bf16 bf16x2_t __attribute__((ext_vector_type(2)));
__device__ __forceinline__ unsigned cvt_pk_bf16(float lo, float hi) { const f32x2 v = {lo, hi}; const bf16x2_t r = __builtin_convertvector(v, bf16x2_t); return __builtin_bit_cast(unsigned, r); }
__device__ __forceinline__ float bf2f(unsigned short b) { return __uint_as_float(((unsigned)b) << 16); }
__device__ __forceinline__ float bflo(unsigned w) { return __uint_as_float(w << 16); }
__device__ __forceinline__ float bfhi(unsigned w) { return __uint_as_float(w & 0xffff0000u); }
__device__ __forceinline__ float wave_sum(float v) {
#pragma unroll
    for (int o = 1; o < 64; o <<= 1) v += __shfl_xor(v, o);
    return v;
}
__device__ __forceinline__ float silu_f(float a) { return a * __builtin_amdgcn_rcpf(1.0f + __expf(-a)); }
#define LDS_WAIT() asm volatile("s_waitcnt lgkmcnt(0)" ::: "memory")
#define MFMA16(a, b, c) __builtin_amdgcn_mfma_f32_16x16x32_bf16((a), (b), (c), 0, 0, 0)

__device__ __forceinline__ f32x2 gelu_pk(f32x2 v) {
    const f32x2 av = __builtin_elementwise_abs(v), d = av * 0.2316418882f + 1.0f;
    f32x2 t; t.x = __builtin_amdgcn_rcpf(d.x); t.y = __builtin_amdgcn_rcpf(d.y);
    f32x2 q = t * 0.5307027145f + (-0.7265760135f); q = q * t + 0.7107068705f; q = q * t + (-0.142248368f); q = q * t + 0.127414796f; q = q * t;
    const f32x2 s = (v * v) * (-0.72134752044f);
    f32x2 e; e.x = __builtin_amdgcn_exp2f(s.x); e.y = __builtin_amdgcn_exp2f(s.y);
    const f32x2 z = {0.f, 0.f};
    return __builtin_elementwise_max(v, z) - av * (q * e);
}

constexpr int BM = 256, BK = 64, HALF = 128, HTB = HALF * BK * 2, NXCD = 8, WGM = 8;
__device__ __forceinline__ int lds_byte(int r, int c) { const int st = (r >> 4) * 2 + (c >> 5), rr = r & 15, cc = c & 31, ob = rr * 64 + cc * 2; return st * 1024 + (ob ^ (((ob >> 9) & 1) << 5)); }
__device__ __forceinline__ void stage_rc(int b, int& R, int& C) { const int st = b / 1024, sb = b % 1024, swz = sb ^ (((sb >> 9) & 1) << 5); R = (st >> 1) * 16 + swz / 64; C = (st & 1) * 32 + (swz % 64) / 2; }
__device__ __forceinline__ int perm32(int rho) { const int n = rho >> 4, i = rho & 15; return 8 * (i >> 2) + 4 * n + (i & 3); }

struct Unit { int pm, pn; };
struct StaticOrder {
    int nM, nN, nwg, G, c;
    __device__ void init(int M, int N, int G_, int c_) { nM = M / BM; nN = N / BM; nwg = nM * nN; G = G_; c = c_; }
    __device__ bool next(int i, Unit& u) const {
        const long L = (long)i * G + c; if (L >= nwg) return false;
        int wgid = (int)L; { const int q = nwg / NXCD, r = nwg % NXCD, xcd = wgid % NXCD, off = wgid / NXCD; wgid = (xcd < r ? xcd * (q + 1) : r * (q + 1) + (xcd - r) * q) + off; }
        const int nig = WGM * nN, gid = wgid / nig, fm = gid * WGM, gsz = (nM - fm) < WGM ? (nM - fm) : WGM;
        u.pm = fm + ((wgid % nig) % gsz); u.pn = (wgid % nig) / gsz; return true;
    }
};

template <int kind> struct Epi {
    static constexpr bool perm = true;
    static constexpr bool PRE = (kind == 3 || kind == 4 || kind == 2 || kind == 5);
    __device__ __forceinline__ void pre(LAS unsigned char* lx, const Unit& u, int wid, int lane) const {
        if constexpr (kind == 2 || kind == 5) {
            const int bi = (u.pm * BM) >> 13;
            if (wid < 4) __builtin_amdgcn_global_load_lds((const unsigned*)(gate + bi * 6144 + u.pn * BM + wid * 64 + lane), (LAS unsigned*)(lx + wid * 256), 4, 0, 0);
            else if (kind == 2) __builtin_amdgcn_global_load_lds((const unsigned*)(gn + bi * 1024 + u.pn * BM + (wid - 4) * 64 + lane), (LAS unsigned*)(lx + 1024 + (wid - 4) * 256), 4, 0, 0);
        } else if constexpr (PRE) {
            const unsigned* src = (const unsigned*)(ssr + (size_t)u.pm * BM) + wid * 64 + lane;
            __builtin_amdgcn_global_load_lds(src, (LAS unsigned*)(lx + wid * 256), 4, 0, 0);
            if (wid < 4) { const int bi = u.pm * BM < MLAT ? ((u.pm * BM) >> 13) : 8; const float* s2 = shb + bi * shn + u.pn * BM + wid * 64 + lane;
                __builtin_amdgcn_global_load_lds((const unsigned*)s2, (LAS unsigned*)(lx + 2048 + wid * 256), 4, 0, 0); }
        }
    }
    bf16_t* U; bf16_t* V; const float* bias; unsigned long long* stats;
    float* xlat; float* xctx; const float* gate;
    bf16_t* xg; const float* gn; unsigned long long* ssw;
    const long long* ssr; const float* shb; int shn;
    bf16_t* hid;
    bf16_t* proj; const float* lbtab;
    __device__ __forceinline__ void operator()(const f32x4 (&acc)[2][2][4][2], const Unit& u, int wr, int wc, int fr, int fq, LAS unsigned char* lx) const {
        if constexpr (kind == 1) {
            const int row0 = u.pm * BM + wr * 64 + fr; int colt = u.pn * BM; const bool vh = colt >= 3072; bf16_t* base = vh ? V : U; if (vh) colt -= 3072;
            const int col0 = colt + wc * 32 + 8 * fq, bcol0 = u.pn * BM + wc * 32 + 8 * fq;
            f32x4 bv[2][2];
#pragma unroll
            for (int bj = 0; bj < 2; ++bj)
#pragma unroll
                for (int n = 0; n < 2; ++n) bv[bj][n] = *(const f32x4*)(bias + bcol0 + bj * HALF + 4 * n);
#pragma unroll
            for (int ai = 0; ai < 2; ++ai)
#pragma unroll
                for (int m = 0; m < 4; ++m) {
                    const int row = row0 + ai * HALF + m * 16; bf16_t* rowp = base + (size_t)row * 3072 + col0; float s = 0.f, ss = 0.f;
#pragma unroll
                    for (int bj = 0; bj < 2; ++bj) {
                        f32x4 v0 = acc[ai][bj][m][0] + bv[bj][0], v1 = acc[ai][bj][m][1] + bv[bj][1];
                        f32x2 a = (f32x2){v0[0], v0[1]}, b = (f32x2){v0[2], v0[3]}, c = (f32x2){v1[0], v1[1]}, d = (f32x2){v1[2], v1[3]};
                        if (vh) { a = gelu_pk(a); b = gelu_pk(b); c = gelu_pk(c); d = gelu_pk(d);
                            s += (a.x + a.y) + (b.x + b.y) + (c.x + c.y) + (d.x + d.y);
                            ss += (a.x * a.x + a.y * a.y) + (b.x * b.x + b.y * b.y) + (c.x * c.x + c.y * c.y) + (d.x * d.x + d.y * d.y); }
                        u32x4 w; w.x = cvt_pk_bf16(a.x, a.y); w.y = cvt_pk_bf16(b.x, b.y); w.z = cvt_pk_bf16(c.x, c.y); w.w = cvt_pk_bf16(d.x, d.y);
                        *(u32x4*)(rowp + bj * HALF) = w;
                    }
                    if (vh) {
                        s += __shfl_xor(s, 16); s += __shfl_xor(s, 32); ss += __shfl_xor(ss, 16); ss += __shfl_xor(ss, 32);
                        if (fq == 0) { atomicAdd(stats + 2 * row, (unsigned long long)(long long)llrintf(s * 1048576.0f)); atomicAdd(stats + 2 * row + 1, (unsigned long long)(long long)llrintf(ss * 1048576.0f)); }
                    }
                }
        } else if constexpr (kind == 2 || kind == 5) {
            const int rowbase = u.pm * BM;
            bf16_t* Xb = (bf16_t*)xlat + (size_t)rowbase * 2048;
            const int col0 = u.pn * BM + wc * 32 + 8 * fq;
            float ss[2][4];
#pragma unroll
            for (int ai = 0; ai < 2; ++ai)
#pragma unroll
                for (int m = 0; m < 4; ++m) ss[ai][m] = 0.f;
#define R_LOAD(X, BJ, AI) do { _Pragma("unroll") for (int m = 0; m < 4; ++m) X[m] = *(const u32x4*)(Xb + (size_t)(wr * 64 + fr + (AI) * HALF + m * 16) * 2048 + col0 + (BJ) * HALF); } while (0)
#define R_PROC(X, BJ, AI) do { const LAS float* lg = (const LAS float*)lx + (BJ) * HALF + wc * 32 + 8 * fq; \
                _Pragma("unroll") for (int m = 0; m < 4; ++m) { const int rl = wr * 64 + fr + (AI) * HALF + m * 16; const int co = col0 + (BJ) * HALF; const u32x4 xi = X[m]; \
                    const f32x4 gv0 = *(const volatile LAS f32x4*)lg, gv1 = *(const volatile LAS f32x4*)(lg + 4);   \
                    f32x4 gn0 = gv0, gn1 = gv1; if constexpr (kind == 2) { gn0 = *(const volatile LAS f32x4*)(lg + 256); gn1 = *(const volatile LAS f32x4*)(lg + 260); } \
                    const f32x4 x0 = (f32x4){bflo(xi.x), bfhi(xi.x), bflo(xi.y), bfhi(xi.y)} + gv0 * acc[AI][BJ][m][0], x1 = (f32x4){bflo(xi.z), bfhi(xi.z), bflo(xi.w), bfhi(xi.w)} + gv1 * acc[AI][BJ][m][1]; \
                    u32x4 xo; xo.x = cvt_pk_bf16(x0[0], x0[1]); xo.y = cvt_pk_bf16(x0[2], x0[3]); xo.z = cvt_pk_bf16(x1[0], x1[1]); xo.w = cvt_pk_bf16(x1[2], x1[3]); \
                    *(u32x4*)(Xb + (size_t)rl * 2048 + co) = xo; \
                    if constexpr (kind == 2) { \
                        ss[AI][m] += ((x0[0] * x0[0] + x0[1] * x0[1]) + (x0[2] * x0[2] + x0[3] * x0[3])) + ((x1[0] * x1[0] + x1[1] * x1[1]) + (x1[2] * x1[2] + x1[3] * x1[3])); \
                        const f32x4 y0 = x0 * gn0, y1 = x1 * gn1; \
                        u32x4 o; o.x = cvt_pk_bf16(y0[0], y0[1]); o.y = cvt_pk_bf16(y0[2], y0[3]); o.z = cvt_pk_bf16(y1[0], y1[1]); o.w = cvt_pk_bf16(y1[2], y1[3]); \
                        *(u32x4*)(xg + (size_t)(rowbase + rl) * 1024 + co) = o; } } } while (0)
            u32x4 xa[4], xb[4], xc_[4], xd[4];
            R_LOAD(xa, 0, 0); R_LOAD(xb, 0, 1);
            R_PROC(xa, 0, 0);
            R_LOAD(xc_, 1, 0);
            R_PROC(xb, 0, 1);
            R_LOAD(xd, 1, 1);
            R_PROC(xc_, 1, 0);
            R_PROC(xd, 1, 1);
#undef R_LOAD
#undef R_PROC
            if constexpr (kind == 2) {
#pragma unroll
                for (int ai = 0; ai < 2; ++ai)
#pragma unroll
                    for (int m = 0; m < 4; ++m) { float t = ss[ai][m]; t += __shfl_xor(t, 16); t += __shfl_xor(t, 32);
                        if (fq == 0) atomicAdd(ssw + rowbase + wr * 64 + fr + ai * HALF + m * 16, (unsigned long long)(long long)llrintf(t * 1048576.0f)); }
            }
        } else if constexpr (kind == 3) {
            const int rowbase = u.pm * BM; const int bi = rowbase < MLAT ? (rowbase >> 13) : 8;
            const int row0 = rowbase + wr * 64 + fr, col0 = u.pn * HALF + wc * 32 + 8 * fq;
            const LAS float* sp = (const LAS float*)(lx + 2048) + wc * 32 + 8 * fq;
            const f32x4 sa0 = *(const LAS f32x4*)sp, sa1 = *(const LAS f32x4*)(sp + 4), sb0 = *(const LAS f32x4*)(sp + HALF), sb1 = *(const LAS f32x4*)(sp + HALF + 4);
#pragma unroll
            for (int ai = 0; ai < 2; ++ai)
#pragma unroll
                for (int m = 0; m < 4; ++m) { const int row = row0 + ai * HALF + m * 16; bf16_t* rowp = hid + (size_t)row * 2816 + col0;
                    const float rs = __builtin_amdgcn_rsqf((float)(*(const LAS long long*)(lx + (wr * 64 + fr + ai * HALF + m * 16) * 8)) * (1.0f / (1048576.0f * 1024.0f)) + EPS);
                    const f32x4 a0 = acc[ai][0][m][0] * rs + sa0, a1 = acc[ai][0][m][1] * rs + sa1, b0 = acc[ai][1][m][0] * rs + sb0, b1 = acc[ai][1][m][1] * rs + sb1;
                    u32x4 w; w.x = cvt_pk_bf16(silu_f(a0[0]) * b0[0], silu_f(a0[1]) * b0[1]); w.y = cvt_pk_bf16(silu_f(a0[2]) * b0[2], silu_f(a0[3]) * b0[3]);
                    w.z = cvt_pk_bf16(silu_f(a1[0]) * b1[0], silu_f(a1[1]) * b1[1]); w.w = cvt_pk_bf16(silu_f(a1[2]) * b1[2], silu_f(a1[3]) * b1[3]);
                    *(u32x4*)rowp = w; }
        } else {
            const int sec = u.pn >> 2; const int row0 = u.pm * BM + wr * 64 + fr, col0 = (u.pn & 3) * BM + wc * 32 + 8 * fq;
            bf16_t* base = proj + (size_t)sec * SECE;
            float rs[2][4];
#pragma unroll
            for (int ai = 0; ai < 2; ++ai)
#pragma unroll
                for (int m = 0; m < 4; ++m) rs[ai][m] = __builtin_amdgcn_rsqf((float)(*(const LAS long long*)(lx + (wr * 64 + fr + ai * HALF + m * 16) * 8)) * (1.0f / (1048576.0f * 1024.0f)) + EPS);
#pragma unroll
            for (int bj = 0; bj < 2; ++bj) {
                const LAS float* sp = (const LAS float*)(lx + 2048) + wc * 32 + 8 * fq + bj * HALF;
                const f32x4 sh0 = *(const LAS f32x4*)sp, sh1 = *(const LAS f32x4*)(sp + 4);
                f32x4 lb0 = (f32x4){0.f, 0.f, 0.f, 0.f}, lb1 = lb0;
                if (sec == 1 || sec == 2) { const float* lp = lbtab + (sec - 1) * 1024 + col0 + bj * HALF; lb0 = *(const f32x4*)lp; lb1 = *(const f32x4*)(lp + 4); }
#pragma unroll
                for (int ai = 0; ai < 2; ++ai)
#pragma unroll
                    for (int m = 0; m < 4; ++m) { bf16_t* rowp = base + (size_t)(row0 + ai * HALF + m * 16) * 1024 + col0;
                        f32x4 v0 = acc[ai][bj][m][0] * rs[ai][m] + sh0, v1 = acc[ai][bj][m][1] * rs[ai][m] + sh1;
                        if (sec == 0 || sec == 4) {
#pragma unroll
                            for (int j = 0; j < 4; ++j) { v0[j] = silu_f(v0[j]); v1[j] = silu_f(v1[j]); }
                        } else if (sec == 1 || sec == 2) {
#pragma unroll
                            for (int j = 0; j < 4; ++j) {
                                v0[j] = lb0[j] * __builtin_amdgcn_rcpf(1.0f + __expf(v0[j]));
                                v1[j] = lb1[j] * __builtin_amdgcn_rcpf(1.0f + __expf(v1[j])); }
                        }
                        u32x4 w; w.x = cvt_pk_bf16(v0[0], v0[1]); w.y = cvt_pk_bf16(v0[2], v0[3]); w.z = cvt_pk_bf16(v1[0], v1[1]); w.w = cvt_pk_bf16(v1[2], v1[3]);
                        *(u32x4*)(rowp + bj * HALF) = w; }
            }
        }
    }
};

template <class EpiT> __device__ __forceinline__ void gemm_phase(LAS unsigned char* lds, const bf16_t* gA, const bf16_t* gBt, int M, int N, int K, const StaticOrder& S, const EpiT& E) {
    const int tid = threadIdx.x, wid = __builtin_amdgcn_readfirstlane(tid >> 6), lane = tid & 63, wr = wid >> 2, wc = wid & 3, fr = lane & 15, fq = lane >> 4;
    const int nt = K / BK;
    unsigned voffA[2], voffB[2];
#pragma unroll
    for (int i = 0; i < 2; ++i) { int R, C; stage_rc(tid * 16 + i * 8192, R, C); const int Rb = EpiT::perm ? ((R & ~31) + perm32(R & 31)) : R;
        voffA[i] = (unsigned)(R * K + C) * 2u; voffB[i] = (unsigned)(Rb * K + C) * 2u; }
    const size_t kstep = (size_t)(BK * 2);
    const size_t hstep = (size_t)HALF * K * 2;
    const size_t tstep = 2 * hstep;
    const unsigned ldsw = (unsigned)wid * 1024u;
    const int aoff = lds_byte(wr * 64 + fr, fq * 8), boff = lds_byte(wc * 32 + fr, fq * 8);
#define PG8_SA(b, h) (((b) * 2 + (h)) * HTB)
#define PG8_SB(b, h) ((4 + (b) * 2 + (h)) * HTB)
#define PG8_STAGE(bufoff, gbase, voff) do { _Pragma("unroll") for (int _i = 0; _i < 2; ++_i) \
        __builtin_amdgcn_global_load_lds((const unsigned*)((const char*)(gbase) + (voff)[_i]), (LAS unsigned*)(lds + (bufoff) + ldsw + _i * 8192), 16, 0, 0); } while (0)
#define PG8_LDA(dst, b, h) do { _Pragma("unroll") for (int m = 0; m < 4; ++m) _Pragma("unroll") for (int k = 0; k < 2; ++k) dst[m][k] = *(const LAS bf16x8*)(lds + PG8_SA(b, h) + aoff + m * 2048 + k * 1024); } while (0)
#define PG8_LDB(dst, b, h) do { _Pragma("unroll") for (int n = 0; n < 2; ++n) _Pragma("unroll") for (int k = 0; k < 2; ++k) dst[n][k] = *(const LAS bf16x8*)(lds + PG8_SB(b, h) + boff + n * 2048 + k * 1024); } while (0)
#define PG8_MMA(ai, bj, At, Bt) do { __builtin_amdgcn_s_setprio(1); _Pragma("unroll") for (int m = 0; m < 4; ++m) _Pragma("unroll") for (int n = 0; n < 2; ++n) _Pragma("unroll") for (int k = 0; k < 2; ++k) \
        acc[ai][bj][m][n] = __builtin_amdgcn_mfma_f32_16x16x32_bf16(Bt[n][k], At[m][k], acc[ai][bj][m][n], 0, 0, 0); __builtin_amdgcn_s_setprio(0); } while (0)
#define PG8_WAIT_V(n) asm volatile("s_waitcnt vmcnt(" #n ")" ::: "memory")
#define PG8_WAIT_L(n) asm volatile("s_waitcnt lgkmcnt(" #n ")" ::: "memory")
#define PG8_BAR __builtin_amdgcn_s_barrier()
#define PG8_SCHED __builtin_amdgcn_sched_barrier(0)
    Unit cur, nxt; int ui = 0;
    if (!S.next(0, cur)) return;
    f32x4 acc[2][2][4][2];
#pragma unroll
    for (int a = 0; a < 2; ++a)
#pragma unroll
        for (int b = 0; b < 2; ++b)
#pragma unroll
            for (int m = 0; m < 4; ++m)
#pragma unroll
                for (int n = 0; n < 2; ++n) acc[a][b][m][n] = (f32x4){0.f, 0.f, 0.f, 0.f};
    bf16x8 At[4][2], B0[2][2], B1[2][2];
    const char* cA = (const char*)gA + (size_t)cur.pm * tstep; const char* cB = (const char*)gBt + (size_t)cur.pn * tstep;
    E.pre(lds + XOFF, cur, wid, lane);
    PG8_STAGE(PG8_SB(0, 0), cB, voffB); PG8_STAGE(PG8_SA(0, 0), cA, voffA); PG8_STAGE(PG8_SB(0, 1), cB + hstep, voffB); PG8_STAGE(PG8_SA(0, 1), cA + hstep, voffA);
    if (wr == 1) PG8_BAR;
    PG8_WAIT_V(4); PG8_BAR;
    PG8_STAGE(PG8_SB(1, 0), cB + kstep, voffB); PG8_STAGE(PG8_SA(1, 0), cA + kstep, voffA); PG8_STAGE(PG8_SB(1, 1), cB + hstep + kstep, voffB);
    PG8_WAIT_V(6); PG8_BAR;
    for (;;) {
        const bool has_next = S.next(ui + 1, nxt);
        const char* nA = has_next ? (const char*)gA + (size_t)nxt.pm * tstep : cA; const char* nB = has_next ? (const char*)gBt + (size_t)nxt.pn * tstep : cB;
        for (int t = 0; t < nt; t += 2) {
            const bool last = (t == nt - 2);
            const char* a1 = cA + (size_t)(t + 1) * kstep;
            const char* a2 = last ? nA : cA + (size_t)(t + 2) * kstep; const char* b2 = last ? nB : cB + (size_t)(t + 2) * kstep;
            const char* a3 = a2 + kstep; const char* b3 = b2 + kstep;
            PG8_LDB(B0, 0, 0); PG8_SCHED; PG8_LDA(At, 0, 0); PG8_STAGE(PG8_SA(1, 1), a1 + hstep, voffA);
            PG8_WAIT_L(8); PG8_BAR; PG8_WAIT_L(0); PG8_MMA(0, 0, At, B0); PG8_BAR; PG8_SCHED;
            PG8_LDB(B1, 0, 1); PG8_STAGE(PG8_SB(0, 0), b2, voffB);
            PG8_BAR; PG8_WAIT_L(0); PG8_MMA(0, 1, At, B1); PG8_BAR;
            PG8_LDA(At, 0, 1); PG8_STAGE(PG8_SA(0, 0), a2, voffA);
            PG8_BAR; PG8_WAIT_L(0); PG8_MMA(1, 0, At, B0); PG8_BAR; PG8_SCHED;
            PG8_STAGE(PG8_SB(0, 1), b2 + hstep, voffB);
            PG8_WAIT_V(6); PG8_BAR; PG8_MMA(1, 1, At, B1); PG8_BAR;
            PG8_LDB(B0, 1, 0); PG8_SCHED; PG8_LDA(At, 1, 0); PG8_STAGE(PG8_SA(0, 1), a2 + hstep, voffA);
            PG8_WAIT_L(8); PG8_BAR; PG8_WAIT_L(0); PG8_MMA(0, 0, At, B0); PG8_BAR; PG8_SCHED;
            PG8_LDB(B1, 1, 1); PG8_STAGE(PG8_SB(1, 0), b3, voffB);
            PG8_BAR; PG8_WAIT_L(0); PG8_MMA(0, 1, At, B1); PG8_BAR;
            PG8_LDA(At, 1, 1); PG8_STAGE(PG8_SA(1, 0), a3, voffA);
            PG8_BAR; PG8_WAIT_L(0); PG8_MMA(1, 0, At, B0); PG8_BAR; PG8_SCHED;
            PG8_STAGE(PG8_SB(1, 1), b3 + hstep, voffB);
            PG8_WAIT_V(6); PG8_BAR; PG8_MMA(1, 1, At, B1); PG8_BAR;
        }
        E(acc, cur, wr, wc, fr, fq, lds + XOFF + (ui & 1) * 3072);
        if (!has_next) break;
        E.pre(lds + XOFF + ((ui + 1) & 1) * 3072, nxt, wid, lane);
#pragma unroll
        for (int a = 0; a < 2; ++a)
#pragma unroll
            for (int b = 0; b < 2; ++b)
#pragma unroll
                for (int m = 0; m < 4; ++m)
#pragma unroll
                    for (int n = 0; n < 2; ++n) acc[a][b][m][n] = (f32x4){0.f, 0.f, 0.f, 0.f};
        cur = nxt; cA = nA; cB = nB; ++ui;
    }
    PG8_WAIT_V(0);
    if (wr == 0) PG8_BAR;
    PG8_BAR;
#undef PG8_SA
#undef PG8_SB
#undef PG8_STAGE
#undef PG8_LDA
#undef PG8_LDB
#undef PG8_MMA
#undef PG8_WAIT_V
#undef PG8_WAIT_L
#undef PG8_BAR
#undef PG8_SCHED
}

__device__ __forceinline__ void transpose_item(const float* W, int K, int N, bf16_t* WT, int dest_row0, int k0, int n0, LAS float* scr, int lane) {
#pragma unroll 8
    for (int i = 0; i < 32; ++i) { const int kk = 2 * i + (lane >> 5); scr[kk * 33 + (lane & 31)] = W[(size_t)(k0 + kk) * N + n0 + (lane & 31)]; }
    LDS_WAIT();
    const int c = lane & 7;
#pragma unroll
    for (int j = 0; j < 4; ++j) { const int n = (lane >> 3) + 8 * j; const LAS float* s = scr + (8 * c) * 33 + n;
        u32x4 o; o.x = cvt_pk_bf16(s[0 * 33], s[1 * 33]); o.y = cvt_pk_bf16(s[2 * 33], s[3 * 33]); o.z = cvt_pk_bf16(s[4 * 33], s[5 * 33]); o.w = cvt_pk_bf16(s[6 * 33], s[7 * 33]);
        *(u32x4*)(WT + (size_t)(dest_row0 + n) * K + k0 + 8 * c) = o; }
    LDS_WAIT();
}

__device__ __forceinline__ void prep_phase(const Params& p, LAS unsigned char* lds) {
    const int tid = threadIdx.x, lane = tid & 63, w = __builtin_amdgcn_readfirstlane(tid >> 6);
    unsigned char* ws = p.ws;
    {
        LAS float* sS = (LAS float*)(lds + 73728);
        LAS float* part = (LAS float*)(lds + 110592);
        float* mod = (float*)(ws + OFF_MOD);
        for (int it = blockIdx.x; it < 192; it += gridDim.x) {
            const int layer = it / 96, n0 = (it % 96) * 64;
            for (int idx = tid; idx < 9216; idx += 512) { const int j = idx >> 10, k = idx & 1023; const float v = j < 8 ? p.in[1][j * 1024 + k] : p.in[3][k]; sS[idx] = v / (1.0f + __expf(-v)); }
            __syncthreads();
            float a[9];
#pragma unroll
            for (int j = 0; j < 9; ++j) a[j] = 0.f;
            const float* wp = p.in[4] + ((size_t)layer * 1024 + w * 128) * 6144 + n0 + lane;
#pragma unroll 8
            for (int kk = 0; kk < 128; ++kk) { const float wv = wp[(size_t)kk * 6144];
#pragma unroll
                for (int j = 0; j < 9; ++j) a[j] += sS[j * 1024 + w * 128 + kk] * wv; }
#pragma unroll
            for (int j = 0; j < 9; ++j) part[(w * 9 + j) * 64 + lane] = a[j];
            __syncthreads();
            for (int idx = tid; idx < 576; idx += 512) { const int j = idx >> 6, l = idx & 63; float s = p.in[5][layer * 6144 + n0 + l];
#pragma unroll
                for (int ww = 0; ww < 8; ++ww) s += part[(ww * 9 + j) * 64 + l];
                mod[(layer * 9 + j) * 6144 + n0 + l] = s; }
            __syncthreads();
        }
    }
    {
        LAS float* scr = (LAS float*)(lds + w * 8448);
        const int gw = blockIdx.x * 8 + w, NGW = gridDim.x * 8;
        for (int it = gw; it < 16128; it += NGW) {
            int r = it; const float* W; bf16_t* WT; int K, N, swz = 0;
            if (r < 3072) { W = p.in[8]; WT = (bf16_t*)(ws + W_GMIN); K = 1024; N = 6144; }
            else if ((r -= 3072) < 1536) { W = p.in[14]; WT = (bf16_t*)(ws + W_GMOUT); K = 3072; N = 1024; }
            else if ((r -= 1536) < 2560) { W = p.in[15]; WT = (bf16_t*)(ws + W_HGIN); K = 1024; N = 5120; }
            else if ((r -= 2560) < 512) { W = p.in[18]; WT = (bf16_t*)(ws + W_HGOUT); K = 1024; N = 1024; }
            else if ((r -= 512) < 5632) { const int l = r / 2816; r -= l * 2816; W = p.in[19] + (size_t)l * 1024 * 5632; WT = (bf16_t*)(ws + W_FFIN) + (size_t)l * 5632 * 1024; K = 1024; N = 5632; swz = 1; }
            else { r -= 5632; const int l = r / 1408; r -= l * 1408; W = p.in[20] + (size_t)l * 2816 * 1024; WT = (bf16_t*)(ws + W_FFOUT) + (size_t)l * 1024 * 2816; K = 2816; N = 1024; }
            const int nblk = N / 32, kb = r / nblk, nb = r % nblk, k0 = 64 * kb, n0 = 32 * nb;
            int dest = n0;
            if (swz) { if (n0 < 2816) dest = (n0 >> 7) * 256 + (n0 & 127); else { const int j = n0 - 2816; dest = (j >> 7) * 256 + 128 + (j & 127); } }
            transpose_item(W, K, N, WT, dest, k0, n0, scr, lane);
        }
    }
    const int gt = blockIdx.x * 512 + tid, NT = gridDim.x * 512;
    { bf16_t* wsb = (bf16_t*)(ws + W_WS); for (int i = gt; i < 65536; i += NT) { const float a = p.in[12][2 * i], b = p.in[12][2 * i + 1]; ((unsigned*)wsb)[i] = cvt_pk_bf16(a, b); } }
    { unsigned long long* st = (unsigned long long*)(ws + OFF_STATS); for (int i = gt; i < MALL * 2; i += NT) st[i] = 0ull; }
    { unsigned long long* st = (unsigned long long*)(ws + OFF_SS); for (int i = gt; i < MALL * 3; i += NT) st[i] = 0ull; }
    { float* pos = (float*)(ws + OFF_POS); for (int i = gt; i < 192 * 512; i += NT) { const int pp = i >> 9, j = i & 511; const float ps = (float)(pp < 128 ? pp : pp - 128);
            const float om = expf(-(float)(j & 255) * (9.210340371976184f / 256.0f)); const float ang = ps * om; pos[i] = j < 256 ? sinf(ang) : cosf(ang); } }
    { float* lb = (float*)(ws + OFF_LB); for (int i = gt; i < 2048; i += NT) { const float l0 = p.in[16][i], l1 = p.in[16][2048 + i]; lb[i] = 1.0f - 1.0f / (1.0f + expf(l0 - l1)); } }
}

__device__ __forceinline__ void modrms_phase(const Params& p, int layer, int which, int nrows, bool first) {
    const int lane = threadIdx.x & 63, w = __builtin_amdgcn_readfirstlane(threadIdx.x >> 6);
    const int gw = blockIdx.x * 8 + w, NGW = gridDim.x * 8;
    const float* nw = p.in[which ? 7 : 6] + layer * 1024;
    const float* modl = (const float*)(p.ws + OFF_MOD) + layer * 9 * 6144 + (which ? 3 : 0) * 1024;
    const float* pos = (const float*)(p.ws + OFF_POS);
    bf16_t* H = (bf16_t*)(p.ws + OFF_H);
    float* xc = (float*)(p.ws + OFF_XC);
    for (int row0 = gw; row0 < nrows; row0 += 2 * NGW) {
        f32x4 v[2][4];
#pragma unroll
        for (int r = 0; r < 2; ++r) { const int row = row0 + r * NGW;
            if (row < nrows) {
                float* xp = row < MLAT ? p.out + (size_t)row * 1024 : xc + (size_t)(row - MLAT) * 1024;
                if (first) {
                    const float* src = row < MLAT ? p.in[0] + (size_t)row * 1024 : p.in[2] + (size_t)(row - MLAT) * 1024;
#pragma unroll
                    for (int j = 0; j < 4; ++j) v[r][j] = *(const f32x4*)(src + 256 * j + 4 * lane);
                    if (row < MLAT) { const int t = row & 8191, pr = t >> 6, pc = t & 63;
#pragma unroll
                        for (int j = 0; j < 4; ++j) { const float* pp = j < 2 ? pos + pr * 512 + 256 * j + 4 * lane : pos + (128 + pc) * 512 + 256 * (j - 2) + 4 * lane; v[r][j] = v[r][j] + *(const f32x4*)pp; } }
                } else {
#pragma unroll
                    for (int j = 0; j < 4; ++j) v[r][j] = *(const f32x4*)(xp + 256 * j + 4 * lane);
                }
            } else {
#pragma unroll
                for (int j = 0; j < 4; ++j) v[r][j] = (f32x4){0.f, 0.f, 0.f, 0.f};
            } }
#pragma unroll
        for (int r = 0; r < 2; ++r) { const int row = row0 + r * NGW;
            if (row < nrows) {
                const int bi = row < MLAT ? (row >> 13) : 8;
                float* xp = row < MLAT ? p.out + (size_t)row * 1024 : xc + (size_t)(row - MLAT) * 1024;
                if (first) {
                    if (row < MLAT) { bf16_t* xb = (bf16_t*)p.out + (size_t)row * 2048;
#pragma unroll
                        for (int j = 0; j < 4; ++j) { u32x2 o; o.x = cvt_pk_bf16(v[r][j][0], v[r][j][1]); o.y = cvt_pk_bf16(v[r][j][2], v[r][j][3]); *(u32x2*)(xb + 256 * j + 4 * lane) = o; }
                    } else {
#pragma unroll
                        for (int j = 0; j < 4; ++j) *(f32x4*)(xp + 256 * j + 4 * lane) = v[r][j];
                    }
                }
                float ss = 0.f;
#pragma unroll
                for (int j = 0; j < 4; ++j) ss += (v[r][j][0] * v[r][j][0] + v[r][j][1] * v[r][j][1]) + (v[r][j][2] * v[r][j][2] + v[r][j][3] * v[r][j][3]);
                ss = wave_sum(ss);
                const float rstd = rsqrtf(ss * (1.0f / 1024.0f) + EPS);
                const float* sh = modl + bi * 6144; const float* sc = sh + 1024;
#pragma unroll
                for (int j = 0; j < 4; ++j) { const int c = 256 * j + 4 * lane; const f32x4 w4 = *(const f32x4*)(nw + c), s4 = *(const f32x4*)(sh + c), c4 = *(const f32x4*)(sc + c);
                    const f32x4 h = v[r][j] * rstd * w4 * (c4 + 1.0f) + s4; u32x2 o; o.x = cvt_pk_bf16(h[0], h[1]); o.y = cvt_pk_bf16(h[2], h[3]);
                    *(u32x2*)(H + (size_t)row * 1024 + c) = o; }
            } }
    }
}

__device__ __forceinline__ void tables_phase(const Params& p, LAS unsigned char* lds) {
    const int tid = threadIdx.x, lane = tid & 63, w = __builtin_amdgcn_readfirstlane(tid >> 6);
    unsigned char* ws = p.ws;
    const float* mod = (const float*)(ws + OFF_MOD);
    float* GN = (float*)(ws + OFF_GN); float* SHB = (float*)(ws + OFF_SHB);
    const int gt = blockIdx.x * 512 + tid, NT = gridDim.x * 512;
    for (int i = gt; i < 3 * 9216; i += NT) { const int n = i / 9216, r = i % 9216, b = r >> 10, k = r & 1023; const int layer = n == 0 ? 0 : 1, which = n == 1 ? 0 : 1;
        GN[i] = p.in[which ? 7 : 6][layer * 1024 + k] * (1.0f + mod[(layer * 9 + b) * 6144 + (which ? 4 : 1) * 1024 + k]); }
    LAS float* sS = (LAS float*)lds;
    for (int it = blockIdx.x; it < 256; it += gridDim.x) {
        int n, r0; const bf16_t* wt; const float* sh;
        if (it < 88) { n = 0; r0 = it * 64; wt = (const bf16_t*)(ws + W_FFIN) + (size_t)r0 * 1024; sh = mod + 3 * 1024; }
        else if (it < 168) { n = 1; r0 = (it - 88) * 64; wt = (const bf16_t*)(ws + W_HGIN) + (size_t)r0 * 1024; sh = mod + 9 * 6144; }
        else { n = 2; r0 = (it - 168) * 64; wt = (const bf16_t*)(ws + W_FFIN) + (size_t)(5632 + r0) * 1024; sh = mod + 9 * 6144 + 3 * 1024; }
        __syncthreads();
        for (int i = tid; i < 9216; i += 512) sS[i] = sh[(i >> 10) * 6144 + (i & 1023)];
        __syncthreads();
        u32x4 wv[8][2];
#pragma unroll
        for (int j = 0; j < 8; ++j) { const bf16_t* wr_ = wt + (size_t)(w * 8 + j) * 1024 + lane * 16; wv[j][0] = *(const u32x4*)wr_; wv[j][1] = *(const u32x4*)(wr_ + 8); }
        for (int b = 0; b < 9; ++b) {
            f32x4 s4[4];
#pragma unroll
            for (int i = 0; i < 4; ++i) s4[i] = *(const LAS f32x4*)(sS + b * 1024 + lane * 16 + 4 * i);
#pragma unroll
            for (int j = 0; j < 8; ++j) { float d = 0.f;
#pragma unroll
                for (int i = 0; i < 4; ++i) { const unsigned a0 = wv[j][i >> 1][(i & 1) * 2], a1 = wv[j][i >> 1][(i & 1) * 2 + 1];
                    d += (bflo(a0) * s4[i][0] + bfhi(a0) * s4[i][1]) + (bflo(a1) * s4[i][2] + bfhi(a1) * s4[i][3]); }
                d = wave_sum(d);
                if (lane == 0) SHB[(n * 9 + b) * 5632 + r0 + w * 8 + j] = d; }
        }
    }
}

__device__ __forceinline__ void final_phase(const Params& p) {
    const int lane = threadIdx.x & 63, w = __builtin_amdgcn_readfirstlane(threadIdx.x >> 6);
    const int gw = blockIdx.x * 8 + w, NGW = gridDim.x * 8;
    const float* fw = p.in[21];
    f32x4 w4[4];
#pragma unroll
    for (int j = 0; j < 4; ++j) w4[j] = *(const f32x4*)(fw + lane * 16 + 4 * j);
    for (int row0 = gw; row0 < MLAT; row0 += 2 * NGW) {
        u32x4 a[2][2];
#pragma unroll
        for (int r = 0; r < 2; ++r) { const int row = row0 + r * NGW; const bf16_t* xb = (const bf16_t*)p.out + (size_t)(row < MLAT ? row : row0) * 2048 + lane * 16;
            a[r][0] = *(const u32x4*)xb; a[r][1] = *(const u32x4*)(xb + 8); }
        asm volatile("s_waitcnt vmcnt(0)" ::: "memory");
#pragma unroll
        for (int r = 0; r < 2; ++r) { const int row = row0 + r * NGW;
            if (row < MLAT) {
                f32x4 v[4];
                v[0] = (f32x4){bflo(a[r][0].x), bfhi(a[r][0].x), bflo(a[r][0].y), bfhi(a[r][0].y)}; v[1] = (f32x4){bflo(a[r][0].z), bfhi(a[r][0].z), bflo(a[r][0].w), bfhi(a[r][0].w)};
                v[2] = (f32x4){bflo(a[r][1].x), bfhi(a[r][1].x), bflo(a[r][1].y), bfhi(a[r][1].y)}; v[3] = (f32x4){bflo(a[r][1].z), bfhi(a[r][1].z), bflo(a[r][1].w), bfhi(a[r][1].w)};
                float ss = 0.f;
#pragma unroll
                for (int j = 0; j < 4; ++j) ss += (v[j][0] * v[j][0] + v[j][1] * v[j][1]) + (v[j][2] * v[j][2] + v[j][3] * v[j][3]);
                ss = wave_sum(ss); const float rstd = rsqrtf(ss * (1.0f / 1024.0f) + EPS);
                float* op = p.out + (size_t)row * 1024 + lane * 16;
#pragma unroll
                for (int j = 0; j < 4; ++j) *(f32x4*)(op + 4 * j) = v[j] * rstd * w4[j];
            } }
    }
}

__device__ __forceinline__ void spatial_phase(const Params& p, LAS unsigned char* lds) {
    const int tid = threadIdx.x, lane = tid & 63, w = __builtin_amdgcn_readfirstlane(tid >> 6), fr = lane & 15, fq = lane >> 4, wp = w >> 1, wcn = w & 1;
    bf16_t* U = (bf16_t*)(p.ws + OFF_U); const bf16_t* V = (const bf16_t*)(p.ws + OFF_V);
    const long long* stats = (const long long*)(p.ws + OFF_STATS); const bf16_t* Wsb = (const bf16_t*)(p.ws + W_WS);
    const float* lng = p.in[10]; const float* lnb = p.in[11]; const float* bs = p.in[13];
    LAS unsigned* VT = (LAS unsigned*)lds;
    const int ck = tid & 15, c = ck * 8, qp0 = tid >> 4;
    constexpr int NITEM = 528 * 24;
    u32x4 va[2], vb[2]; long long st[2][4]; f32x4 g0, g1, b0, b1;
    int item = blockIdx.x;
    if (item < NITEM) { const int ritem = NITEM - 1 - item; const int ci = ritem / 24, sl = ritem % 24, r0 = ci * 128, c0 = sl * 128;
#pragma unroll
        for (int it = 0; it < 2; ++it) { const int q = (qp0 + it * 32) * 2; va[it] = *(const u32x4*)(V + (size_t)(r0 + q) * 3072 + c0 + c); vb[it] = *(const u32x4*)(V + (size_t)(r0 + q + 1) * 3072 + c0 + c);
            const long long* stp = stats + 2 * (r0 + q); st[it][0] = stp[0]; st[it][1] = stp[1]; st[it][2] = stp[2]; st[it][3] = stp[3]; }
        g0 = *(const f32x4*)(lng + c0 + c); g1 = *(const f32x4*)(lng + c0 + c + 4); b0 = *(const f32x4*)(lnb + c0 + c); b1 = *(const f32x4*)(lnb + c0 + c + 4); }
    for (; item < NITEM; item += gridDim.x) {
        const int ritem = NITEM - 1 - item;
        const int ci = ritem / 24, sl = ritem % 24, g = sl / 3, r0 = ci * 128, c0 = sl * 128;
        bf16x8 Wf[2][4];
#pragma unroll
        for (int rt = 0; rt < 2; ++rt)
#pragma unroll
            for (int ks = 0; ks < 4; ++ks) Wf[rt][ks] = *(const bf16x8*)(Wsb + ((size_t)(g * 128 + wp * 32 + rt * 16 + fr) * 128 + ks * 32 + fq * 8));
        u32x4 uu[2][2]; float bsv[2];
#pragma unroll
        for (int rt = 0; rt < 2; ++rt) { const int pr = wp * 32 + rt * 16 + fr; bsv[rt] = bs[g * 128 + pr];
#pragma unroll
            for (int cp2 = 0; cp2 < 2; ++cp2) uu[rt][cp2] = *(const u32x4*)(U + (size_t)(r0 + pr) * 3072 + c0 + wcn * 64 + cp2 * 32 + fq * 8); }
#pragma unroll
        for (int it = 0; it < 2; ++it) {
            const int qp = qp0 + it * 32;
            const float FX = 1.0f / (1048576.0f * 3072.0f);
            const float mu0 = (float)st[it][0] * FX, mu1 = (float)st[it][2] * FX;
            const float rs0 = __builtin_amdgcn_rsqf(fmaxf((float)st[it][1] * FX - mu0 * mu0, 0.f) + EPS), rs1 = __builtin_amdgcn_rsqf(fmaxf((float)st[it][3] * FX - mu1 * mu1, 0.f) + EPS);
            const float nm0 = -mu0 * rs0, nm1 = -mu1 * rs1;
#pragma unroll
            for (int i = 0; i < 8; ++i) {
                const unsigned wa = va[it][i >> 1], wb = vb[it][i >> 1];
                const float xa = (i & 1) ? bfhi(wa) : bflo(wa), xb = (i & 1) ? bfhi(wb) : bflo(wb);
                const float gg = i < 4 ? g0[i & 3] : g1[i & 3], bb = i < 4 ? b0[i & 3] : b1[i & 3];
                VT[(c + i) * 68 + (qp ^ (4 * ck))] = cvt_pk_bf16((xa * rs0 + nm0) * gg + bb, (xb * rs1 + nm1) * gg + bb);
            }
        }
        __syncthreads();
        { const int nitem = item + gridDim.x;
            if (nitem < NITEM) { const int rn = NITEM - 1 - nitem; const int nci = rn / 24, nsl = rn % 24, nr0 = nci * 128, nc0 = nsl * 128;
#pragma unroll
                for (int it = 0; it < 2; ++it) { const int q = (qp0 + it * 32) * 2; va[it] = *(const u32x4*)(V + (size_t)(nr0 + q) * 3072 + nc0 + c); vb[it] = *(const u32x4*)(V + (size_t)(nr0 + q + 1) * 3072 + nc0 + c);
                    const long long* stp = stats + 2 * (nr0 + q); st[it][0] = stp[0]; st[it][1] = stp[1]; st[it][2] = stp[2]; st[it][3] = stp[3]; }
                g0 = *(const f32x4*)(lng + nc0 + c); g1 = *(const f32x4*)(lng + nc0 + c + 4); b0 = *(const f32x4*)(lnb + nc0 + c); b1 = *(const f32x4*)(lnb + nc0 + c + 4); } }
        f32x4 acc[2][4];
#pragma unroll
        for (int rt = 0; rt < 2; ++rt)
#pragma unroll
            for (int ct = 0; ct < 4; ++ct) acc[rt][ct] = (f32x4){0.f, 0.f, 0.f, 0.f};
#pragma unroll
        for (int ks = 0; ks < 4; ++ks)
#pragma unroll
            for (int ct = 0; ct < 4; ++ct) {
                const int crow = wcn * 64 + (ct >> 1) * 32 + 8 * (fr >> 2) + 4 * (ct & 1) + (fr & 3);
                const bf16x8 Bf = *(const LAS bf16x8*)(lds + crow * 272 + (((ks * 16 + fq * 4) ^ (4 * ((crow >> 3) & 15))) * 4));
#pragma unroll
                for (int rt = 0; rt < 2; ++rt) acc[rt][ct] = MFMA16(Bf, Wf[rt][ks], acc[rt][ct]);
            }
#pragma unroll
        for (int rt = 0; rt < 2; ++rt) { const int pr = wp * 32 + rt * 16 + fr;
#pragma unroll
            for (int cp2 = 0; cp2 < 2; ++cp2) { bf16_t* up = U + (size_t)(r0 + pr) * 3072 + c0 + wcn * 64 + cp2 * 32 + fq * 8; const u32x4 u4 = uu[rt][cp2];
                const f32x2 ga = gelu_pk((f32x2){bflo(u4.x), bfhi(u4.x)}), gb = gelu_pk((f32x2){bflo(u4.y), bfhi(u4.y)}), gc = gelu_pk((f32x2){bflo(u4.z), bfhi(u4.z)}), gd = gelu_pk((f32x2){bflo(u4.w), bfhi(u4.w)});
                const f32x4 a0 = acc[rt][2 * cp2] + bsv[rt], a1 = acc[rt][2 * cp2 + 1] + bsv[rt];
                u32x4 o; o.x = cvt_pk_bf16(a0[0] * ga.x, a0[1] * ga.y); o.y = cvt_pk_bf16(a0[2] * gb.x, a0[3] * gb.y); o.z = cvt_pk_bf16(a1[0] * gc.x, a1[1] * gc.y); o.w = cvt_pk_bf16(a1[2] * gd.x, a1[3] * gd.y);
                *(u32x4*)up = o; } }
        __syncthreads();
    }
}

__device__ __forceinline__ int scan_base(int c, int b, int dir) {
    return c < 4 ? (MLAT + b * 256 + (dir ? 255 - c * 64 : c * 64)) : (b * 8192 + (dir ? 8191 - (c - 4) * 64 : (c - 4) * 64));
}
__device__ __forceinline__ void scan_phase(const Params& p, LAS unsigned char* lds) {
    const int tid = threadIdx.x, lane = tid & 63, w = __builtin_amdgcn_readfirstlane(tid >> 6), fr = lane & 15, fq = lane >> 4;
    constexpr int SET = 62976, oKI = 17408, oKDT = 34816, oVT = 53248, oDD = 62464;
    LAS unsigned char* ATT = lds + 125952; LAS unsigned char* ST = lds + 135168; LAS float* SEGT = (LAS float*)(lds + 152576);
    const bf16_t* sec0 = (const bf16_t*)(p.ws + OFF_U);
    bf16_t* OF = (bf16_t*)(p.ws + OFF_V + 2 * SEC); bf16_t* OB = (bf16_t*)(p.ws + OFF_H);
    const int cp = tid & 63, seg = tid >> 6, dvv = tid & 63, ts = tid >> 6;
#define SCAN_LOAD(cc) do { const int _b = scan_base((cc), b, dir); _Pragma("unroll") for (int i = 0; i < 8; ++i) { const int row = _b + sgn * (seg * 8 + i); \
        rq[i] = *(const unsigned*)(Qp + (size_t)row * 1024); rk[i] = *(const unsigned*)(Kp + (size_t)row * 1024); rv[i] = Vp[(size_t)row * 1024]; } } while (0)
#define SCAN_UNPACK() do { _Pragma("unroll") for (int i = 0; i < 8; ++i) { q0[i] = bflo(rq[i]); q1[i] = bfhi(rq[i]); k0[i] = bflo(rk[i]); k1[i] = bfhi(rk[i]); } \
        vpk.x = (unsigned)rv[0] | ((unsigned)rv[1] << 16); vpk.y = (unsigned)rv[2] | ((unsigned)rv[3] << 16); vpk.z = (unsigned)rv[4] | ((unsigned)rv[5] << 16); vpk.w = (unsigned)rv[6] | ((unsigned)rv[7] << 16); } while (0)
#define SCAN_P1() do { float r0 = 1.f, r1 = 1.f; _Pragma("unroll") for (int i = 0; i < 8; ++i) { r0 *= (1.0f - k0[i]); r1 *= (1.0f - k1[i]); c0[i] = r0; c1[i] = r1; } \
        *(LAS f32x2*)(SEGT + seg * 128 + 2 * cp) = (f32x2){r0, r1}; } while (0)
#define SCAN_P2(so) do { LAS unsigned char* _QD = lds + (so); LAS unsigned char* _KI = _QD + oKI; LAS unsigned char* _KDT = _QD + oKDT; LAS unsigned char* _VT = _QD + oVT; LAS float* _DD = (LAS float*)(_QD + oDD); \
        float of0 = 1.f, of1 = 1.f, tt0 = 1.f, tt1 = 1.f; \
        _Pragma("unroll") for (int s_ = 0; s_ < 8; ++s_) { const f32x2 t = *(const LAS f32x2*)(SEGT + s_ * 128 + 2 * cp); tt0 *= t.x; tt1 *= t.y; of0 *= (s_ < seg) ? t.x : 1.f; of1 *= (s_ < seg) ? t.y : 1.f; } \
        unsigned kda[4], kdb[4]; \
        _Pragma("unroll") for (int i = 0; i < 8; i += 2) { float kd0[2], kd1[2]; \
            _Pragma("unroll") for (int e = 0; e < 2; ++e) { const float e0 = of0 * c0[i + e], e1 = of1 * c1[i + e]; const float r0 = __builtin_amdgcn_rcpf(e0), r1 = __builtin_amdgcn_rcpf(e1); const int t = seg * 8 + i + e; \
                *(LAS unsigned*)(_QD + (t * 136 + 2 * cp) * 2) = cvt_pk_bf16(q0[i + e] * e0, q1[i + e] * e1); \
                *(LAS unsigned*)(_KI + (t * 136 + 2 * cp) * 2) = cvt_pk_bf16(k0[i + e] * r0, k1[i + e] * r1); \
                kd0[e] = k0[i + e] * (tt0 * r0); kd1[e] = k1[i + e] * (tt1 * r1); } \
            kda[i >> 1] = cvt_pk_bf16(kd0[0], kd0[1]); kdb[i >> 1] = cvt_pk_bf16(kd1[0], kd1[1]); } \
        *(LAS u32x4*)(_KDT + ((2 * cp) * 72 + seg * 8) * 2) = (u32x4){kda[0], kda[1], kda[2], kda[3]}; \
        *(LAS u32x4*)(_KDT + ((2 * cp + 1) * 72 + seg * 8) * 2) = (u32x4){kdb[0], kdb[1], kdb[2], kdb[3]}; \
        if (seg == 0) *(LAS f32x2*)(_DD + 2 * cp) = (f32x2){tt0, tt1}; \
        *(LAS u32x4*)(_VT + (dvv * 72 + ts * 8) * 2) = vpk; } while (0)
    for (int chain = blockIdx.x; chain < 256; chain += gridDim.x) {
        const int vh = chain & 1, dir = (chain >> 1) & 1, h = (chain >> 2) & 7, b = chain >> 5;
        const bf16_t* Qp = sec0 + h * 128 + 2 * cp;
        const bf16_t* Kp = sec0 + (size_t)(1 + dir) * SECE + h * 128 + 2 * cp;
        const bf16_t* Vp = sec0 + (size_t)3 * SECE + h * 128 + vh * 64 + dvv;
        bf16_t* Op = (dir ? OB : OF) + h * 128 + vh * 64;
        const int sgn = dir ? -1 : 1;
        f32x4 S[4];
#pragma unroll
        for (int i = 0; i < 4; ++i) S[i] = (f32x4){0.f, 0.f, 0.f, 0.f};
        for (int i = tid; i < 4352; i += 512) ((LAS unsigned*)ST)[i] = 0u;
        unsigned rq[8], rk[8]; unsigned short rv[8];
        float q0[8], q1[8], k0[8], k1[8], c0[8], c1[8]; u32x4 vpk;
        SCAN_LOAD(0);
        SCAN_UNPACK();
        SCAN_LOAD(1);
        SCAN_P1();
        __syncthreads();
        SCAN_P2(0);
        __syncthreads();
        for (int c = 0; c < 132; ++c) {
            const int base = scan_base(c, b, dir);
            const int so = (c & 1) * SET;
            LAS unsigned char* QD = lds + so; LAS unsigned char* KI = QD + oKI; LAS unsigned char* KDT = QD + oKDT; LAS unsigned char* VT = QD + oVT; LAS float* DD = (LAS float*)(QD + oDD);
            if (c > 0) {
#pragma unroll
                for (int dt = 0; dt < 4; ++dt) { u32x2 o; o.x = cvt_pk_bf16(S[dt][0], S[dt][1]); o.y = cvt_pk_bf16(S[dt][2], S[dt][3]);
                    *(LAS u32x2*)(ST + ((dt * 16 + fr) * 136 + w * 16 + fq * 4) * 2) = o; }
            }
            if (c + 1 < 132) { SCAN_UNPACK(); if (c + 2 < 132) SCAN_LOAD(c + 2); SCAN_P1(); }
            bf16x8 qf[4];
#pragma unroll
            for (int ks = 0; ks < 4; ++ks) qf[ks] = (bf16x8){0, 0, 0, 0, 0, 0, 0, 0};
            if (c >= 4) { const int ti = w >> 1;
#pragma unroll
                for (int ks = 0; ks < 4; ++ks) qf[ks] = *(const LAS bf16x8*)(QD + ((ti * 16 + fr) * 136 + ks * 32 + fq * 8) * 2);
#pragma unroll
                for (int sj = 0; sj < 2; ++sj) { const int si = (w & 1) * 2 + sj; f32x4 a = (f32x4){0.f, 0.f, 0.f, 0.f};
                    if (si <= ti) {
#pragma unroll
                        for (int ks = 0; ks < 4; ++ks) { const bf16x8 X = *(const LAS bf16x8*)(KI + ((si * 16 + fr) * 136 + ks * 32 + fq * 8) * 2);
                            a = MFMA16(X, qf[ks], a); }
                        const int tg = ti * 16 + fr, sg = si * 16 + fq * 4;
#pragma unroll
                        for (int j = 0; j < 4; ++j) a[j] = (sg + j <= tg) ? a[j] : 0.f;
                    }
                    u32x2 o; o.x = cvt_pk_bf16(a[0], a[1]); o.y = cvt_pk_bf16(a[2], a[3]);
                    *(LAS u32x2*)(ATT + ((ti * 16 + fr) * 72 + si * 16 + fq * 4) * 2) = o; } }
            __syncthreads();
            if (c + 1 < 132) SCAN_P2(SET - so);
            if (c >= 4) { const int ti = w >> 1;
#pragma unroll
                for (int dj = 0; dj < 2; ++dj) { const int di = (w & 1) * 2 + dj; f32x4 a = (f32x4){0.f, 0.f, 0.f, 0.f};
#pragma unroll
                    for (int ks = 0; ks < 2; ++ks) { const bf16x8 X = *(const LAS bf16x8*)(VT + ((di * 16 + fr) * 72 + ks * 32 + fq * 8) * 2), Y = *(const LAS bf16x8*)(ATT + ((ti * 16 + fr) * 72 + ks * 32 + fq * 8) * 2);
                        a = MFMA16(X, Y, a); }
#pragma unroll
                    for (int ks = 0; ks < 4; ++ks) { const bf16x8 X = *(const LAS bf16x8*)(ST + ((di * 16 + fr) * 136 + ks * 32 + fq * 8) * 2);
                        a = MFMA16(X, qf[ks], a); }
                    { const int row = base + sgn * (ti * 16 + fr); u32x2 o; o.x = cvt_pk_bf16(a[0], a[1]); o.y = cvt_pk_bf16(a[2], a[3]);
                        *(u32x2*)(Op + (size_t)row * 1024 + di * 16 + fq * 4) = o; } } }
            { const f32x4 dd = *(const LAS f32x4*)(DD + w * 16 + fq * 4);
#pragma unroll
                for (int dt = 0; dt < 4; ++dt) { S[dt] = S[dt] * dd;
#pragma unroll
                    for (int ks = 0; ks < 2; ++ks) { const bf16x8 X = *(const LAS bf16x8*)(KDT + ((w * 16 + fr) * 72 + ks * 32 + fq * 8) * 2), Y = *(const LAS bf16x8*)(VT + ((dt * 16 + fr) * 72 + ks * 32 + fq * 8) * 2);
                        S[dt] = MFMA16(X, Y, S[dt]); } } }
            __syncthreads();
        }
    }
#undef SCAN_LOAD
#undef SCAN_UNPACK
#undef SCAN_P1
#undef SCAN_P2
}

__device__ __forceinline__ void readout_phase(const Params& p) {
    const int lane = threadIdx.x & 63, w = __builtin_amdgcn_readfirstlane(threadIdx.x >> 6);
    const int gw = blockIdx.x * 8 + w, NGW = gridDim.x * 8;
    const bf16_t* OF = (const bf16_t*)(p.ws + OFF_V + 2 * SEC); const bf16_t* OB = (const bf16_t*)(p.ws + OFF_H);
    const bf16_t* G = (const bf16_t*)(p.ws + OFF_U) + (size_t)4 * SECE; bf16_t* R = (bf16_t*)(p.ws + OFF_U);
    const float* nw = p.in[17];
    for (int row0 = gw; row0 < MLAT; row0 += 2 * NGW) {
        u32x4 a[2][2], b[2][2], g[2][2];
#pragma unroll
        for (int r = 0; r < 2; ++r) { const int row = row0 + r * NGW; const size_t o = (size_t)(row < MLAT ? row : row0) * 1024 + lane * 16;
#pragma unroll
            for (int i = 0; i < 2; ++i) { a[r][i] = *(const u32x4*)(OF + o + 8 * i); b[r][i] = *(const u32x4*)(OB + o + 8 * i); g[r][i] = *(const u32x4*)(G + o + 8 * i); } }
#pragma unroll
        for (int r = 0; r < 2; ++r) { const int row = row0 + r * NGW;
            if (row < MLAT) { const size_t o = (size_t)row * 1024 + lane * 16;
                float v[16]; float ss = 0.f;
#pragma unroll
                for (int i = 0; i < 8; ++i) { const unsigned wa = a[r][i >> 2][i & 3], wb = b[r][i >> 2][i & 3]; v[2 * i] = bflo(wa) + bflo(wb); v[2 * i + 1] = bfhi(wa) + bfhi(wb); ss += v[2 * i] * v[2 * i] + v[2 * i + 1] * v[2 * i + 1]; }
                ss += __shfl_xor(ss, 1); ss += __shfl_xor(ss, 2); ss += __shfl_xor(ss, 4);
                const float rstd = rsqrtf(ss * (1.0f / 128.0f) + EPS);
                u32x4 rr[2];
#pragma unroll
                for (int i = 0; i < 8; ++i) { const unsigned wg = g[r][i >> 2][i & 3]; const f32x2 n2 = *(const f32x2*)(nw + lane * 16 + 2 * i);
                    rr[i >> 2][i & 3] = cvt_pk_bf16(v[2 * i] * rstd * n2.x * bflo(wg), v[2 * i + 1] * rstd * n2.y * bfhi(wg)); }
                *(u32x4*)(R + o) = rr[0]; *(u32x4*)(R + o + 8) = rr[1]; } }
    }
}

#define XB_TMO      128
#define XB_XCNT(j)  (256  + 64 * (j))
#define XB_XSUB(j)  (1280 + 64 * (j))
#define XB_XGEN(j)  (2304 + 64 * (j))
#define XB_TOP      3328
#define XB_TOPGEN   3392
#define XB_SPIN_CAP (1u << 22)
__device__ __forceinline__ unsigned xb_ld(unsigned* p)              { return __hip_atomic_load(p, __ATOMIC_RELAXED, __HIP_MEMORY_SCOPE_AGENT); }
__device__ __forceinline__ unsigned xb_add(unsigned* p, unsigned v) { return __hip_atomic_fetch_add(p, v, __ATOMIC_RELAXED, __HIP_MEMORY_SCOPE_AGENT); }
__device__ __forceinline__ unsigned xb_xcc_id() { return (unsigned)__builtin_amdgcn_s_getreg((3 << 11) | 20) & 0xFu; }
#define XB_SPIN(cond, bar) do { unsigned _sp = 0; while (cond) { __builtin_amdgcn_s_sleep(1); \
    if ((++_sp & 255u) == 0u) { if (xb_ld(&(bar)[XB_TMO])) break; if (_sp > XB_SPIN_CAP) { atomicAdd(&(bar)[XB_TMO], 1u); break; } } } } while (0)
struct XcdBarrier { unsigned* bar; unsigned x; volatile LAS unsigned* st; };
__device__ __forceinline__ XcdBarrier xcd_barrier_post(unsigned* bar, volatile LAS unsigned* st) {
    XcdBarrier b; b.bar = bar; b.x = xb_xcc_id(); b.st = st;
    if (threadIdx.x == 0) (void)xb_add(&bar[XB_XCNT(b.x)], 1u);
    return b;
}
__device__ __forceinline__ void xcd_barrier_complete(unsigned* bar, unsigned x, unsigned& nloc, unsigned& nx) {
    const unsigned G = gridDim.x * gridDim.y * gridDim.z;
    unsigned sum, cnt, mine, sp = 0u;
    for (;;) {
        sum = 0u; cnt = 0u; mine = 0u;
#pragma unroll
        for (unsigned j = 0; j < 16; ++j) { const unsigned c = xb_ld(&bar[XB_XCNT(j)]); sum += c; cnt += (c > 0u) ? 1u : 0u; mine = (j == x) ? c : mine; }
        if (sum == G) break;
        __builtin_amdgcn_s_sleep(1);
        if ((++sp & 255u) == 0u) { if (xb_ld(&bar[XB_TMO])) break; if (sp > XB_SPIN_CAP) { atomicAdd(&bar[XB_TMO], 1u); break; } }
    }
    nloc = mine > 0u ? mine : 1u; nx = cnt > 0u ? cnt : 1u;
}
__device__ __forceinline__ void xcd_barrier(const XcdBarrier& b) {
    asm volatile("s_waitcnt vmcnt(0)" ::: "memory");
    __syncthreads();
    if (threadIdx.x == 0) {
        unsigned* bar = b.bar;
        __builtin_amdgcn_s_waitcnt(0);
        unsigned nloc = b.st[0], nx = b.st[1];
        if (nloc == 0u) { xcd_barrier_complete(bar, b.x, nloc, nx); b.st[0] = nloc; b.st[1] = nx; }
        const unsigned old = xb_add(&bar[XB_XSUB(b.x)], 1u);
        const unsigned gen = old / nloc;
        if (old + 1u == (gen + 1u) * nloc) {
            __builtin_amdgcn_fence(__ATOMIC_RELEASE, "agent");
            asm volatile("s_waitcnt vmcnt(0)" ::: "memory");
            const unsigned og = xb_add(&bar[XB_TOP], 1u);
            const unsigned tg = og / nx;
            if (og + 1u == (tg + 1u) * nx) xb_add(&bar[XB_TOPGEN], 1u);
            else XB_SPIN(xb_ld(&bar[XB_TOPGEN]) == tg, bar);
            __builtin_amdgcn_fence(__ATOMIC_ACQUIRE, "agent");
            xb_add(&bar[XB_XGEN(b.x)], 1u);
            asm volatile("s_waitcnt vmcnt(0)" ::: "memory");
        } else {
            XB_SPIN(xb_ld(&bar[XB_XGEN(b.x)]) == gen, bar);
            __builtin_amdgcn_fence(__ATOMIC_ACQUIRE, "agent");
            asm volatile("s_waitcnt vmcnt(0)" ::: "memory");
        }
    }
    __syncthreads();
}

__device__ __forceinline__ void ctx_gemm_phase(LAS unsigned char* lds, const bf16_t* A, const bf16_t* Wt, int K, const float* gate, const float* gn, unsigned long long* ssw, bf16_t* xg, float* xc) {
    const int tid = threadIdx.x, lane = tid & 63, w = __builtin_amdgcn_readfirstlane(tid >> 6), fr = lane & 15, fq = lane >> 4, wr = w >> 2, wc = w & 3;
    const int ns = K / 128;
    for (int t = blockIdx.x; t < 256; t += gridDim.x) {
        const int rt = t >> 3, ct = t & 7;
        const bf16_t* ag[2]; const bf16_t* bg[4]; int lofA[2], lofB[4];
#pragma unroll
        for (int q = 0; q < 2; ++q) { const int pz = tid + 512 * q, row = pz >> 4, c16 = pz & 15; ag[q] = A + (size_t)(rt * 64 + row) * K + c16 * 8; lofA[q] = row * 272 + c16 * 16; }
#pragma unroll
        for (int q = 0; q < 4; ++q) { const int pz = tid + 512 * q, row = pz >> 4, c16 = pz & 15; bg[q] = Wt + (size_t)(ct * 128 + row) * K + c16 * 8; lofB[q] = 17408 + row * 272 + c16 * 16; }
        f32x4 acc[2][2];
#pragma unroll
        for (int i = 0; i < 2; ++i)
#pragma unroll
            for (int j = 0; j < 2; ++j) acc[i][j] = (f32x4){0.f, 0.f, 0.f, 0.f};
        u32x4 r0[6], r1[6], r2[6];
#define CG_LD(R, S) do { _Pragma("unroll") for (int q = 0; q < 2; ++q) R[q] = *(const u32x4*)(ag[q] + (S) * 128); _Pragma("unroll") for (int q = 0; q < 4; ++q) R[2 + q] = *(const u32x4*)(bg[q] + (S) * 128); } while (0)
#define CG_ST(R, BUF) do { LAS unsigned char* _b = lds + (BUF) * 52224; _Pragma("unroll") for (int q = 0; q < 2; ++q) *(LAS u32x4*)(_b + lofA[q]) = R[q]; _Pragma("unroll") for (int q = 0; q < 4; ++q) *(LAS u32x4*)(_b + lofB[q]) = R[2 + q]; } while (0)
#define CG_MM(BUF) do { const LAS unsigned char* _b = lds + (BUF) * 52224; _Pragma("unroll") for (int u = 0; u < 4; ++u) { bf16x8 Af[2], Bf[2]; \
            _Pragma("unroll") for (int i = 0; i < 2; ++i) { Af[i] = *(const LAS bf16x8*)(_b + (wr * 32 + i * 16 + fr) * 272 + (u * 32 + fq * 8) * 2); Bf[i] = *(const LAS bf16x8*)(_b + 17408 + (wc * 32 + i * 16 + fr) * 272 + (u * 32 + fq * 8) * 2); } \
            _Pragma("unroll") for (int i = 0; i < 2; ++i) _Pragma("unroll") for (int j = 0; j < 2; ++j) acc[i][j] = MFMA16(Bf[j], Af[i], acc[i][j]); } } while (0)
        CG_LD(r0, 0); CG_LD(r1, 1); CG_LD(r2, 2);
        CG_ST(r0, 0);
        __syncthreads();
        for (int s0 = 0; s0 < ns; s0 += 3) {
            { if (s0 + 1 < ns) CG_ST(r1, (s0 + 1) & 1); if (s0 + 3 < ns) CG_LD(r0, s0 + 3); CG_MM(s0 & 1); __syncthreads(); }
            if (s0 + 1 < ns) { if (s0 + 2 < ns) CG_ST(r2, (s0 + 2) & 1); if (s0 + 4 < ns) CG_LD(r1, s0 + 4); CG_MM((s0 + 1) & 1); __syncthreads(); }
            if (s0 + 2 < ns) { if (s0 + 3 < ns) CG_ST(r0, (s0 + 3) & 1); if (s0 + 5 < ns) CG_LD(r2, s0 + 5); CG_MM((s0 + 2) & 1); __syncthreads(); }
        }
#undef CG_LD
#undef CG_ST
#undef CG_MM
        f32x4 xin[2][2], gvv[2], gnn[2];
#pragma unroll
        for (int j = 0; j < 2; ++j) { const int c = ct * 128 + wc * 32 + j * 16 + fq * 4; gvv[j] = *(const f32x4*)(gate + c); gnn[j] = *(const f32x4*)(gn + c);
#pragma unroll
            for (int i = 0; i < 2; ++i) xin[i][j] = *(const f32x4*)(xc + (size_t)(rt * 64 + wr * 32 + i * 16 + fr) * 1024 + c); }
#pragma unroll
        for (int i = 0; i < 2; ++i) { const int r = rt * 64 + wr * 32 + i * 16 + fr; float ss = 0.f;
#pragma unroll
            for (int j = 0; j < 2; ++j) { const int c = ct * 128 + wc * 32 + j * 16 + fq * 4;
                const f32x4 gv = gvv[j], gnv = gnn[j];
                f32x4 x = xin[i][j] + gv * acc[i][j]; *(f32x4*)(xc + (size_t)r * 1024 + c) = x;
                ss += (x[0] * x[0] + x[1] * x[1]) + (x[2] * x[2] + x[3] * x[3]);
                const f32x4 y = x * gnv; u32x2 o; o.x = cvt_pk_bf16(y[0], y[1]); o.y = cvt_pk_bf16(y[2], y[3]); *(u32x2*)(xg + (size_t)r * 1024 + c) = o; }
            ss += __shfl_xor(ss, 16); ss += __shfl_xor(ss, 32);
            if (fq == 0) atomicAdd(ssw + r, (unsigned long long)(long long)llrintf(ss * 1048576.0f)); }
    }
}

__global__ void __launch_bounds__(512, 2) fwd_kernel(Params p) {
    extern __shared__ __attribute__((aligned(16))) unsigned char lds_raw[];
    LAS unsigned char* lds = (LAS unsigned char*)lds_raw;
    unsigned char* ws = p.ws;
    const int lo = p.ph_lo, hi = p.ph_hi;
    volatile LAS unsigned* bst = (volatile LAS unsigned*)(lds + BST_OFF);
    if (threadIdx.x < 2) bst[threadIdx.x] = 0u;
    __syncthreads();
    XcdBarrier bar; bar.bar = (unsigned*)(ws + OFF_BAR); bar.x = 0; bar.st = bst;
    if (hi - lo > 1) bar = xcd_barrier_post((unsigned*)(ws + OFF_BAR), bst);
#define IN(k) (lo <= (k) && (k) < hi)
#define SEAM(k) do { if (IN(k) && hi - lo > 1) { if ((k) == 0) cg::this_grid().sync(); else xcd_barrier(bar); if (DUP(20)) { xcd_barrier(bar); xcd_barrier(bar); } } } while (0)
#define MODP ((const float*)(ws + OFF_MOD))
#define GEMM_RUN(E, A_, B_, M_, N_, K_) do { StaticOrder S; S.init((M_), (N_), (int)gridDim.x, (int)blockIdx.x); gemm_phase(lds, (const bf16_t*)(A_), (const bf16_t*)(B_), (M_), (N_), (K_), S, E); } while (0)
    if (IN(0)) { prep_phase(p, lds); if (DUP(0)) { __syncthreads(); prep_phase(p, lds); } }
    SEAM(0);
    if (IN(1)) { modrms_phase(p, 0, 0, MALL, true); tables_phase(p, lds); if (DUP(1)) { __syncthreads(); modrms_phase(p, 0, 0, MALL, true); tables_phase(p, lds); } }
    SEAM(1);
    if (IN(2)) { Epi<1> E{}; E.U = (bf16_t*)(ws + OFF_U); E.V = (bf16_t*)(ws + OFF_V); E.bias = p.in[9]; E.stats = (unsigned long long*)(ws + OFF_STATS);
        GEMM_RUN(E, ws + OFF_H, ws + W_GMIN, MALL, 6144, 1024); }
    SEAM(2);
    if (IN(3)) spatial_phase(p, lds);
    SEAM(3);
    if (IN(4)) { Epi<2> E{}; E.xlat = p.out; E.xctx = (float*)(ws + OFF_XC); E.gate = MODP + 2 * 1024;
        E.xg = (bf16_t*)(ws + OFF_H); E.gn = (const float*)(ws + OFF_GN); E.ssw = (unsigned long long*)(ws + OFF_SS);
        ctx_gemm_phase(lds, (const bf16_t*)(ws + OFF_U) + (size_t)MLAT * 3072, (const bf16_t*)(ws + W_GMOUT), 3072, MODP + 2 * 1024 + 8 * 6144, (const float*)(ws + OFF_GN) + 8 * 1024,
                       (unsigned long long*)(ws + OFF_SS) + MLAT, (bf16_t*)(ws + OFF_H) + (size_t)MLAT * 1024, (float*)(ws + OFF_XC));
        GEMM_RUN(E, ws + OFF_U, ws + W_GMOUT, MLAT, 1024, 3072); }
    SEAM(4);
    if (IN(6)) { Epi<3> E{}; E.hid = (bf16_t*)(ws + OFF_U); E.ssr = (const long long*)(ws + OFF_SS); E.shb = (const float*)(ws + OFF_SHB); E.shn = 5632;
        GEMM_RUN(E, ws + OFF_H, ws + W_FFIN, MALL, 5632, 1024); if (DUP(6)) GEMM_RUN(E, ws + OFF_H, ws + W_FFIN, MALL, 5632, 1024); }
    SEAM(6);
    if (IN(7)) { Epi<2> E{}; E.xlat = p.out; E.xctx = (float*)(ws + OFF_XC); E.gate = MODP + 5 * 1024;
        E.xg = (bf16_t*)(ws + OFF_H); E.gn = (const float*)(ws + OFF_GN) + 9216; E.ssw = (unsigned long long*)(ws + OFF_SS) + MALL;
        ctx_gemm_phase(lds, (const bf16_t*)(ws + OFF_U) + (size_t)MLAT * 2816, (const bf16_t*)(ws + W_FFOUT), 2816, MODP + 5 * 1024 + 8 * 6144, (const float*)(ws + OFF_GN) + 9216 + 8 * 1024,
                       (unsigned long long*)(ws + OFF_SS) + MALL + MLAT, (bf16_t*)(ws + OFF_H) + (size_t)MLAT * 1024, (float*)(ws + OFF_XC));
        GEMM_RUN(E, ws + OFF_U, ws + W_FFOUT, MLAT, 1024, 2816); }
    SEAM(7);
    if (IN(9)) { Epi<4> E{}; E.proj = (bf16_t*)(ws + OFF_U); E.lbtab = (const float*)(ws + OFF_LB); E.ssr = (const long long*)(ws + OFF_SS) + MALL; E.shb = (const float*)(ws + OFF_SHB) + 9 * 5632; E.shn = 5632;
        GEMM_RUN(E, ws + OFF_H, ws + W_HGIN, MALL, 5120, 1024); }
    SEAM(9);
    if (IN(10)) { scan_phase(p, lds); if (DUP(10)) scan_phase(p, lds); }
    SEAM(10);
    if (IN(11)) { readout_phase(p); if (DUP(11)) readout_phase(p); }
    SEAM(11);
    if (IN(12)) { Epi<2> E{}; E.xlat = p.out; E.xctx = (float*)(ws + OFF_XC); E.gate = MODP + 9 * 6144 + 2 * 1024;
        E.xg = (bf16_t*)(ws + OFF_H); E.gn = (const float*)(ws + OFF_GN) + 2 * 9216; E.ssw = (unsigned long long*)(ws + OFF_SS) + 2 * MALL;
        GEMM_RUN(E, ws + OFF_U, ws + W_HGOUT, MLAT, 1024, 1024); }
    SEAM(12);
    if (IN(14)) { Epi<3> E{}; E.hid = (bf16_t*)(ws + OFF_U); E.ssr = (const long long*)(ws + OFF_SS) + 2 * MALL; E.shb = (const float*)(ws + OFF_SHB) + 2 * 9 * 5632; E.shn = 5632;
        GEMM_RUN(E, ws + OFF_H, ws + W_FFIN + (size_t)5632 * 1024 * 2, MLAT, 5632, 1024); }
    SEAM(14);
    if (IN(15)) { Epi<5> E{}; E.xlat = p.out; E.xctx = (float*)(ws + OFF_XC); E.gate = MODP + 9 * 6144 + 5 * 1024;
        GEMM_RUN(E, ws + OFF_U, ws + W_FFOUT + (size_t)1024 * 2816 * 2, MLAT, 1024, 2816); }
    SEAM(15);
    if (IN(16)) final_phase(p);
#undef IN
#undef SEAM
}

extern "C" void kernel_launch(void* const* d_in, const int* in_sizes, int n_in, void* d_out, int out_size, void* d_ws, size_t ws_size, hipStream_t stream) {
    static int grid = 0;
    if (grid == 0) {
        if (n_in != 22 || ws_size < WS_END) { fprintf(stderr, "kernel_launch: unexpected n_in %d / ws_size %zu (need %zu)\n", n_in, ws_size, (size_t)WS_END); grid = -1; return; }
        int dev = 0, cus = 0, per_cu = 0;
        (void)hipGetDevice(&dev); (void)hipDeviceGetAttribute(&cus, hipDeviceAttributeMultiprocessorCount, dev);
        if (hipFuncSetAttribute((const void*)fwd_kernel, hipFuncAttributeMaxDynamicSharedMemorySize, LDS_BYTES) != hipSuccess) { fprintf(stderr, "kernel_launch: hipFuncSetAttribute failed\n"); grid = -1; return; }
        (void)hipOccupancyMaxActiveBlocksPerMultiprocessor(&per_cu, (const void*)fwd_kernel, 512, LDS_BYTES);
        (void)hipGetLastError();
        if (per_cu < 1) per_cu = 1;
        grid = cus * 1;
        if (grid <= 0) grid = 256;
    }
    if (grid < 0) return;
    Params p{};
    for (int i = 0; i < 22; ++i) p.in[i] = (const float*)d_in[i];
    p.out = (float*)d_out; p.ws = (unsigned char*)d_ws;
#if COOP
    if (hipMemsetAsync((char*)d_ws + OFF_BAR, 0, 16384, stream) != hipSuccess) { fprintf(stderr, "kernel_launch: memset of the barrier words failed\n"); return; }
    p.ph_lo = 0; p.ph_hi = NPHASE;
    void* args[] = {&p};
    hipError_t e = hipLaunchCooperativeKernel((const void*)fwd_kernel, dim3(grid), dim3(512), args, LDS_BYTES, stream);
    if (e != hipSuccess) fprintf(stderr, "cooperative launch failed: %s (grid %d)\n", hipGetErrorString(e), grid);
#else
    for (int ph = 0; ph < NPHASE; ++ph) { p.ph_lo = ph; p.ph_hi = ph + 1; hipLaunchKernelGGL(fwd_kernel, dim3(grid), dim3(512), LDS_BYTES, stream, p); }
#endif
}
```
